# Optimizing an MI355X kernel written in HIP

```python
import math
import jax
import jax.numpy as jnp
from jax import lax
import numpy as np

D_MODEL = 1024
BATCH = 4
SEQ = 8192
DEPTH = 4

GRID_W = 64
CTX_LEN = 256
N_EVEN = (DEPTH + 1) // 2
N_ODD = DEPTH // 2
N_MOD = 9
NORM_EPS = 1e-6
MACARON = 0.5
FFN_HIDDEN = 256 * ((8 * D_MODEL // 3 + 255) // 256)

DA_HEADS = D_MODEL // 128
DA_HEAD_DIM = 64
DA_WIDTH = DA_HEADS * 2 * DA_HEAD_DIM
DA_SUBLN_EPS = 1e-5
Q_BLOCK = 128
ROPE_BASE = 10000.0

SSD_HEAD_DIM = 64
SSD_INNER = D_MODEL
SSD_HEADS = SSD_INNER // SSD_HEAD_DIM
SSD_GROUPS = 2
SSD_STATE = 128
SSD_CONV = 5
SSD_CHUNK = 128
SSD_CONV_DIM = SSD_INNER + 2 * SSD_GROUPS * SSD_STATE
SSD_NORM_EPS = 1e-5
SSD_DT_MIN = 0.001
SSD_DT_MAX = 0.1

EVEN_IN = 3 * DA_WIDTH + SSD_INNER + SSD_CONV_DIM + 2 * SSD_HEADS
EVEN_OUT = DA_WIDTH + SSD_INNER

TM_HEAD = 64
TM_HEADS = D_MODEL // TM_HEAD
TM_DECAY_LORA = 64
TM_AAA_LORA = 64
TM_MV_LORA = 32
TM_GATE_LORA = 160
TM_GN_EPS = 64e-5

kernel_name = 'hybrid_diffattn_ssd_rwkv7_macaron_dit'


def rms_norm(x, w, eps=NORM_EPS):
    xf = x.astype(jnp.float32)
    y = xf * lax.rsqrt(jnp.mean(xf * xf, axis=-1, keepdims=True) + eps)
    return (y * w.astype(jnp.float32)).astype(x.dtype)


def pre_norm(x, mod, nw, s):
    h = rms_norm(x, nw[2 * s])
    return (h * (1 + mod[:, :, 3 * s + 1]) + mod[:, :, 3 * s]).astype(x.dtype)


def post_add(x, y, mod, nw, s, weight):
    return (x + weight * mod[:, :, 3 * s + 2] * rms_norm(y, nw[2 * s + 1])).astype(x.dtype)


def swiglu(h, w_in, w_out):
    gate, up = jnp.split(h @ w_in, 2, axis=-1)
    return (jax.nn.silu(gate) * up) @ w_out


def ffn_sublayer(x, mod, nw, s, w_in, w_out):
    return post_add(x, swiglu(pre_norm(x, mod, nw, s), w_in, w_out), mod, nw, s, MACARON)


def axial_rope_angles(length, dh):
    rows = length // GRID_W
    row = jnp.repeat(jnp.arange(rows, dtype=jnp.float32), GRID_W)
    col = jnp.tile(jnp.arange(GRID_W, dtype=jnp.float32), rows)
    n_freq = dh // 4
    inv_freq = ROPE_BASE ** (-jnp.arange(n_freq, dtype=jnp.float32) / n_freq)
    return row[:, None] * inv_freq, col[:, None] * inv_freq


def rope_rotate(x, ang):
    x1, x2 = jnp.split(x, 2, axis=-1)
    cos = jnp.cos(ang)[:, None, None, :].astype(x.dtype)
    sin = jnp.sin(ang)[:, None, None, :].astype(x.dtype)
    return jnp.concatenate([x1 * cos - x2 * sin, x2 * cos + x1 * sin], axis=-1)


def axial_rope(x, ang_row, ang_col):
    half = x.shape[-1] // 2
    return jnp.concatenate([rope_rotate(x[..., :half], ang_row), rope_rotate(x[..., half:], ang_col)], axis=-1)


def diff_attention(q_lat, k_lat, v_lat, q_ctx, k_ctx, v_ctx, lam, lam_init, subln_w):
    scale = DA_HEAD_DIM ** -0.5

    def attend(q, k, v):
        s = jnp.einsum('bqhmd,bkhmd->bhmqk', q, k).astype(jnp.float32) * scale
        p = jax.nn.softmax(s, axis=-1)
        a = (p[:, :, 0] - lam * p[:, :, 1]).astype(v.dtype)
        return jnp.einsum('bhqk,bkhe->bqhe', a, v)

    bsz, seq_len = q_lat.shape[:2]
    n_blocks = seq_len // Q_BLOCK
    k_all = jnp.concatenate([k_ctx, k_lat], axis=1)
    v_all = jnp.concatenate([v_ctx, v_lat], axis=1)
    q_blocks = jnp.moveaxis(q_lat.reshape(bsz, n_blocks, Q_BLOCK, DA_HEADS, 2, DA_HEAD_DIM), 1, 0)
    o_lat = lax.map(lambda qb: attend(qb, k_all, v_all), q_blocks)
    o_lat = jnp.moveaxis(o_lat, 0, 1).reshape(bsz, seq_len, DA_HEADS, 2 * DA_HEAD_DIM)
    o_ctx = attend(q_ctx, k_ctx, v_ctx)

    def finish(o):
        o = rms_norm(o, subln_w, DA_SUBLN_EPS) * (1.0 - lam_init)
        return o.reshape(o.shape[0], o.shape[1], DA_WIDTH)
    return finish(o_lat), finish(o_ctx)


def depthwise_conv(x, w, b):
    pad = SSD_CONV // 2
    y = lax.conv_general_dilated(x, w[:, None, :].astype(x.dtype), window_strides=(1,), padding=[(pad, pad)],
                                 dimension_numbers=('NWC', 'WIO', 'NWC'), feature_group_count=x.shape[-1])
    return y + b.astype(x.dtype)


def ssd_prepare(xbc, dt_raw, conv_w, conv_b, dt_bias):
    bsz, length, _ = xbc.shape
    xbc = jax.nn.silu(depthwise_conv(xbc, conv_w, conv_b))
    xs, bm, cm = jnp.split(xbc, [SSD_INNER, SSD_INNER + SSD_GROUPS * SSD_STATE], axis=-1)
    xs = xs.reshape(bsz, length, SSD_HEADS, SSD_HEAD_DIM)
    bm = bm.reshape(bsz, length, SSD_GROUPS, SSD_STATE)
    cm = cm.reshape(bsz, length, SSD_GROUPS, SSD_STATE)
    dt = jax.nn.softplus(dt_raw.astype(jnp.float32).reshape(bsz, length, 2, SSD_HEADS) + dt_bias.astype(jnp.float32))
    return xs, bm, cm, dt


def ssd_scan(x, dt, a, bm, cm, h0):
    f32 = jnp.float32
    bsz, length = x.shape[:2]
    nc = length // SSD_CHUNK
    r = SSD_HEADS // SSD_GROUPS
    xc = x.astype(f32).reshape(bsz, nc, SSD_CHUNK, SSD_GROUPS, r, SSD_HEAD_DIM)
    dtc = dt.astype(f32).reshape(bsz, nc, SSD_CHUNK, SSD_GROUPS, r)
    bc = bm.astype(f32).reshape(bsz, nc, SSD_CHUNK, SSD_GROUPS, SSD_STATE)
    cc = cm.astype(f32).reshape(bsz, nc, SSD_CHUNK, SSD_GROUPS, SSD_STATE)
    acs = jnp.cumsum(dtc * a.reshape(SSD_GROUPS, r), axis=2)
    lower = jnp.tril(jnp.ones((SSD_CHUNK, SSD_CHUNK), dtype=bool))
    seg = acs[:, :, :, None] - acs[:, :, None, :]
    decay = jnp.exp(jnp.where(lower[:, :, None, None], seg, -jnp.inf))
    cb = jnp.einsum('bcign,bcjgn->bcijg', cc, bc)
    y_diag = jnp.einsum('bcijgr,bcjgrp->bcigrp', cb[..., None] * decay * dtc[:, :, None], xc)
    to_end = jnp.exp(acs[:, :, -1:] - acs) * dtc
    states = jnp.einsum('bcjgn,bcjgrp->bcgrpn', bc, xc * to_end[..., None])
    chunk_decay = jnp.exp(acs[:, :, -1])

    def step(h, inp):
        s, d = inp
        return h * d[..., None, None] + s, h

    h_last, h_in = lax.scan(step, h0.astype(f32), (jnp.moveaxis(states, 1, 0), jnp.moveaxis(chunk_decay, 1, 0)))
    h_in = jnp.moveaxis(h_in, 0, 1)
    y_off = jnp.einsum('bcign,bcgrpn->bcigrp', cc, h_in) * jnp.exp(acs)[..., None]
    return (y_diag + y_off).reshape(bsz, length, SSD_HEADS, SSD_HEAD_DIM), h_last


def ssd_two_way(xs, bm, cm, dt, a, h0_fwd, h0_bwd):
    rev = lambda t: jnp.flip(t, axis=1)
    y_f, h_f = ssd_scan(xs, dt[:, :, 0], a[0], bm, cm, h0_fwd)
    y_b, h_b = ssd_scan(rev(xs), rev(dt[:, :, 1]), a[1], rev(bm), rev(cm), h0_bwd)
    return y_f + rev(y_b), h_f, h_b


def ssd_output(y, xs, z, d_skip, norm_w):
    bsz, length, _ = z.shape
    y = y + d_skip.astype(jnp.float32)[:, None] * xs.astype(jnp.float32)
    y = y.reshape(bsz, length, SSD_INNER) * jax.nn.silu(z.astype(jnp.float32))
    g = y.reshape(bsz, length, SSD_GROUPS, SSD_INNER // SSD_GROUPS)
    g = g * lax.rsqrt(jnp.mean(g * g, axis=-1, keepdims=True) + SSD_NORM_EPS)
    return (g.reshape(bsz, length, SSD_INNER) * norm_w.astype(jnp.float32)).astype(z.dtype)


def diff_ssd_mixer(h_lat, h_ctx, ang_row, ang_col, layer, w_in, w_out, lam_p, subln_w,
                   conv_w, conv_b, dt_bias, a_log, d_skip, norm_w):
    splits = [DA_WIDTH, 2 * DA_WIDTH, 3 * DA_WIDTH, 3 * DA_WIDTH + SSD_INNER,
              3 * DA_WIDTH + SSD_INNER + SSD_CONV_DIM]

    def project(h):
        bsz, length, _ = h.shape
        q, k, v, z, xbc, dt_raw = jnp.split(h @ w_in, splits, axis=-1)
        q = q.reshape(bsz, length, DA_HEADS, 2, DA_HEAD_DIM)
        k = k.reshape(bsz, length, DA_HEADS, 2, DA_HEAD_DIM)
        v = v.reshape(bsz, length, DA_HEADS, 2 * DA_HEAD_DIM)
        return q, k, v, z, xbc, dt_raw

    q_l, k_l, v_l, z_l, xbc_l, dt_l = project(h_lat)
    q_c, k_c, v_c, z_c, xbc_c, dt_c = project(h_ctx)
    q_l = axial_rope(q_l, ang_row, ang_col)
    k_l = axial_rope(k_l, ang_row, ang_col)

    lam_init = 0.8 - 0.6 * math.exp(-0.3 * layer)
    lp = lam_p.astype(jnp.float32)
    lam = jnp.exp(jnp.sum(lp[0] * lp[1])) - jnp.exp(jnp.sum(lp[2] * lp[3])) + lam_init
    att_l, att_c = diff_attention(q_l, k_l, v_l, q_c, k_c, v_c, lam, lam_init, subln_w)

    a = -jnp.exp(a_log.astype(jnp.float32))
    xs_c, b_c, c_c, dtp_c = ssd_prepare(xbc_c, dt_c, conv_w, conv_b, dt_bias)
    xs_l, b_l, c_l, dtp_l = ssd_prepare(xbc_l, dt_l, conv_w, conv_b, dt_bias)
    h0 = jnp.zeros((h_lat.shape[0], SSD_GROUPS, SSD_HEADS // SSD_GROUPS, SSD_HEAD_DIM, SSD_STATE), jnp.float32)
    y_c, hf_c, hb_c = ssd_two_way(xs_c, b_c, c_c, dtp_c, a, h0, h0)
    y_l, _, _ = ssd_two_way(xs_l, b_l, c_l, dtp_l, a, hf_c, hb_c)
    ssd_l = ssd_output(y_l, xs_l, z_l, d_skip, norm_w)
    ssd_c = ssd_output(y_c, xs_c, z_c, d_skip, norm_w)
    out_l = jnp.concatenate([att_l, ssd_l], axis=-1) @ w_out
    out_c = jnp.concatenate([att_c, ssd_c], axis=-1) @ w_out
    return out_l, out_c


def token_shift_bidir(x):
    xp = jnp.pad(x, ((0, 0), (1, 1), (0, 0)))
    return 0.5 * (xp[:, :-2] + xp[:, 2:])


def split_heads(t):
    return t.reshape(*t.shape[:-1], TM_HEADS, TM_HEAD)


def rwkv_prepare(x, tm, v_first, v_params):
    f32 = jnp.float32
    xx = token_shift_bidir(x) - x
    mu = tm['mu']
    xr, xw, xk, xv, xa, xg = [x + xx * mu[i] for i in range(6)]
    r = xr @ tm['w_r']
    k = xk @ tm['w_k']
    v_raw = xv @ tm['w_v']
    v = v_raw
    if v_params is not None:
        v0, v1, v2 = v_params
        v = v_raw + (v_first - v_raw) * jax.nn.sigmoid(v0 + (xv @ v1) @ v2)
    w_lora = jnp.einsum('eblr,erd->ebld', jnp.tanh(jnp.einsum('bld,edr->eblr', xw, tm['w1'])), tm['w2'])
    w_log = -jax.nn.softplus(-(tm['w0'][:, None, None, :] + w_lora).astype(f32)) - 0.5
    decay = jnp.exp(-jnp.exp(w_log))
    a_lora = jnp.einsum('eblr,erd->ebld', jnp.einsum('bld,edr->eblr', xa, tm['a1']), tm['a2'])
    a = jax.nn.sigmoid((tm['a0'][:, None, None, :] + a_lora).astype(f32))
    g = jax.nn.sigmoid(xg @ tm['g1']) @ tm['g2']
    kk = split_heads((k * tm['k_k']).astype(f32))
    kk = (kk / jnp.maximum(jnp.sqrt(jnp.sum(kk * kk, axis=-1, keepdims=True)), 1e-12)).reshape(k.shape)
    k_dir = k.astype(f32)[None] * (1.0 + (a - 1.0) * tm['k_a'].astype(f32))
    return r, decay, k_dir, v, kk, a, g, v_raw


def wkv_bidir(r, w, k, v, kk, a, s0):
    f32 = jnp.float32
    bsz, length, _ = r.shape

    def both(t):
        t = t.astype(f32)
        return jnp.stack([t, jnp.flip(t, axis=1)])

    def each(t):
        t = t.astype(f32)
        return jnp.stack([t[0], jnp.flip(t[1], axis=1)])

    def steps(t):
        return jnp.moveaxis(t.reshape(2, bsz, length, TM_HEADS, TM_HEAD), 2, 0)

    xs = tuple(steps(t) for t in (both(r), each(w), each(k), both(v), both(kk), each(a)))

    def step(s, inp):
        r_t, w_t, k_t, v_t, kk_t, a_t = inp
        sa = jnp.einsum('ebhvk,ebhk->ebhv', s, -kk_t)
        s = s * w_t[..., None, :] + sa[..., None] * (kk_t * a_t)[..., None, :] + v_t[..., None] * k_t[..., None, :]
        return s, jnp.einsum('ebhvk,ebhk->ebhv', s, r_t)

    s_fin, ys = lax.scan(step, s0, xs)
    y = ys[:, 0] + jnp.flip(ys[:, 1], axis=0)
    return jnp.moveaxis(y, 0, 1).reshape(bsz, length, D_MODEL), s_fin


def rwkv_output(y, r, k_dir, v, g, tm):
    f32 = jnp.float32
    bsz, length, _ = y.shape
    yh = split_heads(y)
    mean = jnp.mean(yh, axis=-1, keepdims=True)
    var = jnp.mean(jnp.square(yh - mean), axis=-1, keepdims=True)
    yn = ((yh - mean) * lax.rsqrt(var + TM_GN_EPS)).reshape(bsz, length, D_MODEL)
    yn = yn * tm['ln_w'].astype(f32) + tm['ln_b'].astype(f32)
    rk = jnp.einsum('blhn,eblhn->blh', split_heads(r.astype(f32) * tm['r_k'].astype(f32)), split_heads(k_dir))
    bonus = (rk[..., None] * split_heads(v.astype(f32))).reshape(bsz, length, D_MODEL)
    return ((yn + bonus) * g.astype(f32)).astype(r.dtype)


def rwkv_mixer(h_lat, h_ctx, tm, v_first, v_params, need_ctx):
    vf_l, vf_c = v_first
    r_c, w_c, k_c, v_c, kk_c, a_c, g_c, vraw_c = rwkv_prepare(h_ctx, tm, vf_c, v_params)
    r_l, w_l, k_l, v_l, kk_l, a_l, g_l, vraw_l = rwkv_prepare(h_lat, tm, vf_l, v_params)
    s0 = jnp.zeros((2, h_lat.shape[0], TM_HEADS, TM_HEAD, TM_HEAD), jnp.float32)
    y_c, s_c = wkv_bidir(r_c, w_c, k_c, v_c, kk_c, a_c, s0)
    y_l, _ = wkv_bidir(r_l, w_l, k_l, v_l, kk_l, a_l, s_c)
    out_l = rwkv_output(y_l, r_l, k_l, v_l, g_l, tm) @ tm['w_o']
    out_c = rwkv_output(y_c, r_c, k_c, v_c, g_c, tm) @ tm['w_o'] if need_ctx else None
    return out_l, out_c, vraw_l, vraw_c


def setup_inputs(seed: int = 0) -> dict:
    key = jax.random.key(seed)
    keys = iter(jax.random.split(key, 64))
    f32 = jnp.float32
    D, F = D_MODEL, FFN_HIDDEN

    def normal(shape, scale):
        return scale * jax.random.normal(next(keys), shape, f32)

    def gain(shape):
        return 1.0 + normal(shape, 0.02)

    dt = jnp.exp(jax.random.uniform(next(keys), (N_EVEN, 2, SSD_HEADS), f32, math.log(SSD_DT_MIN), math.log(SSD_DT_MAX)))
    ssd_dt_bias = dt + jnp.log(-jnp.expm1(-dt))
    ssd_a_log = jnp.log(jax.random.uniform(next(keys), (N_EVEN, 2, SSD_HEADS), f32, 1.0, 16.0))
    tm_mu = jax.random.uniform(next(keys), (N_ODD, 6, D), f32)
    tm_w0 = jnp.linspace(-6.5, -1.5, D, dtype=f32) + normal((N_ODD, 2, D), 0.1)
    return {
        'x': normal((BATCH, SEQ, D), 1.0),
        'c': normal((BATCH, D), 1.0),
        'ctx': normal((BATCH, CTX_LEN, D), 1.0),
        'c_ctx': normal((D,), 1.0),
        'ada_w': normal((DEPTH, D, N_MOD * D), 0.5 * D ** -0.5),
        'ada_b': normal((DEPTH, N_MOD * D), 0.02),
        'norm_w': gain((DEPTH, 6, D)),
        'ffn_w_in': normal((DEPTH, 2, D, 2 * F), D ** -0.5),
        'ffn_w_out': normal((DEPTH, 2, F, D), F ** -0.5),
        'ev_w_in': normal((N_EVEN, D, EVEN_IN), D ** -0.5),
        'ev_w_out': normal((N_EVEN, EVEN_OUT, D), EVEN_OUT ** -0.5),
        'da_lambda': normal((N_EVEN, 4, DA_HEAD_DIM), 0.1),
        'da_subln': gain((N_EVEN, 2 * DA_HEAD_DIM)),
        'ssd_conv_w': normal((N_EVEN, SSD_CONV, SSD_CONV_DIM), SSD_CONV ** -0.5),
        'ssd_conv_b': normal((N_EVEN, SSD_CONV_DIM), 0.02),
        'ssd_dt_bias': ssd_dt_bias,
        'ssd_a_log': ssd_a_log,
        'ssd_d': 1.0 + normal((N_EVEN, SSD_HEADS), 0.1),
        'ssd_norm': gain((N_EVEN, SSD_INNER)),
        'tm_mu': tm_mu,
        'tm_w_r': normal((N_ODD, D, D), D ** -0.5),
        'tm_w_k': normal((N_ODD, D, D), D ** -0.5),
        'tm_w_v': normal((N_ODD, D, D), D ** -0.5),
        'tm_w_o': normal((N_ODD, D, D), D ** -0.5),
        'tm_w0': tm_w0,
        'tm_w1': normal((N_ODD, 2, D, TM_DECAY_LORA), D ** -0.5),
        'tm_w2': normal((N_ODD, 2, TM_DECAY_LORA, D), 0.1 * TM_DECAY_LORA ** -0.5),
        'tm_a0': normal((N_ODD, 2, D), 0.1),
        'tm_a1': normal((N_ODD, 2, D, TM_AAA_LORA), D ** -0.5),
        'tm_a2': normal((N_ODD, 2, TM_AAA_LORA, D), 0.1 * TM_AAA_LORA ** -0.5),
        'tm_g1': normal((N_ODD, D, TM_GATE_LORA), D ** -0.5),
        'tm_g2': normal((N_ODD, TM_GATE_LORA, D), TM_GATE_LORA ** -0.5),
        'tm_k_k': 0.85 + normal((N_ODD, D), 0.02),
        'tm_k_a': 1.0 + normal((N_ODD, D), 0.02),
        'tm_r_k': normal((N_ODD, D), 0.1),
        'tm_ln_w': gain((N_ODD, D)),
        'tm_ln_b': normal((N_ODD, D), 0.02),
        'tm_v0': 1.0 + normal((N_ODD - 1, D), 0.1),
        'tm_v1': normal((N_ODD - 1, D, TM_MV_LORA), D ** -0.5),
        'tm_v2': normal((N_ODD - 1, TM_MV_LORA, D), 0.1 * TM_MV_LORA ** -0.5),
    }


def reference(x, c, ctx, c_ctx, ada_w, ada_b, norm_w, ffn_w_in, ffn_w_out,
              ev_w_in, ev_w_out, da_lambda, da_subln, ssd_conv_w, ssd_conv_b,
              ssd_dt_bias, ssd_a_log, ssd_d, ssd_norm,
              tm_mu, tm_w_r, tm_w_k, tm_w_v, tm_w_o, tm_w0, tm_w1, tm_w2,
              tm_a0, tm_a1, tm_a2, tm_g1, tm_g2, tm_k_k, tm_k_a, tm_r_k,
              tm_ln_w, tm_ln_b, tm_v0, tm_v1, tm_v2):
    bsz, seq_len, _ = x.shape
    ang_row, ang_col = axial_rope_angles(seq_len, DA_HEAD_DIM)
    x_lat, x_ctx = x, ctx
    v_first = (None, None)
    for l in range(DEPTH):
        last = l == DEPTH - 1
        j = l // 2
        mod_l = (jax.nn.silu(c) @ ada_w[l] + ada_b[l]).reshape(bsz, 1, N_MOD, D_MODEL)
        mod_c = (jax.nn.silu(c_ctx) @ ada_w[l] + ada_b[l]).reshape(1, 1, N_MOD, D_MODEL)
        nw = norm_w[l]
        x_lat = ffn_sublayer(x_lat, mod_l, nw, 0, ffn_w_in[l, 0], ffn_w_out[l, 0])
        x_ctx = ffn_sublayer(x_ctx, mod_c, nw, 0, ffn_w_in[l, 0], ffn_w_out[l, 0])
        h_lat = pre_norm(x_lat, mod_l, nw, 1)
        h_ctx = pre_norm(x_ctx, mod_c, nw, 1)
        if l % 2 == 0:
            y_lat, y_ctx = diff_ssd_mixer(h_lat, h_ctx, ang_row, ang_col, l, ev_w_in[j], ev_w_out[j],
                                          da_lambda[j], da_subln[j], ssd_conv_w[j], ssd_conv_b[j],
                                          ssd_dt_bias[j], ssd_a_log[j], ssd_d[j], ssd_norm[j])
        else:
            tm = {'mu': tm_mu[j], 'w_r': tm_w_r[j], 'w_k': tm_w_k[j], 'w_v': tm_w_v[j], 'w_o': tm_w_o[j],
                  'w0': tm_w0[j], 'w1': tm_w1[j], 'w2': tm_w2[j], 'a0': tm_a0[j], 'a1': tm_a1[j], 'a2': tm_a2[j],
                  'g1': tm_g1[j], 'g2': tm_g2[j], 'k_k': tm_k_k[j], 'k_a': tm_k_a[j], 'r_k': tm_r_k[j],
                  'ln_w': tm_ln_w[j], 'ln_b': tm_ln_b[j]}
            v_params = (tm_v0[j - 1], tm_v1[j - 1], tm_v2[j - 1]) if j > 0 else None
            y_lat, y_ctx, v_l, v_c = rwkv_mixer(h_lat, h_ctx, tm, v_first, v_params, not last)
            if j == 0:
                v_first = (v_l, v_c)
        x_lat = post_add(x_lat, y_lat, mod_l, nw, 1, 1.0)
        x_lat = ffn_sublayer(x_lat, mod_l, nw, 2, ffn_w_in[l, 1], ffn_w_out[l, 1])
        if not last:
            x_ctx = post_add(x_ctx, y_ctx, mod_c, nw, 1, 1.0)
            x_ctx = ffn_sublayer(x_ctx, mod_c, nw, 2, ffn_w_in[l, 1], ffn_w_out[l, 1])
    return x_lat
```

```cpp
#include <hip/hip_runtime.h>
#include <hip/hip_cooperative_groups.h>
#include <cstdio>
#include <cstring>
#include <cstdint>
namespace cg = cooperative_groups;

typedef unsigned short bf16;
using bf16x8 = __attribute__((ext_vector_type(8))) short;
using bf16x4 = __attribute__((ext_vector_type(4))) short;
using f32x4 = __attribute__((ext_vector_type(4))) float;
#define DI __device__ __forceinline__

constexpr int D = 1024, NB = 4, CL = 256, TB = 8448, M = 33792, FH = 2816;
constexpr size_t U = (size_t)M * D * 2;

constexpr size_t OFF_H = 0;
constexpr size_t OFF_Y = U;
constexpr size_t OFF_BIG = 2 * U;
constexpr size_t OFF_VF = OFF_BIG + 4 * U + U / 2;
constexpr size_t OFF_W = OFF_VF + U;
constexpr size_t W_STRIDE = 25432064;
constexpr size_t W_ELEMS = 2 * W_STRIDE;
constexpr size_t OFF_TW = OFF_W + W_ELEMS * 2;
constexpr size_t OFF_TA = OFF_TW + (size_t)M * 128 * 2;
constexpr size_t OFF_TG = OFF_TA + (size_t)M * 128 * 2;
constexpr size_t OFF_TV = OFF_TG + (size_t)M * 160 * 2;
constexpr size_t OFF_DT = OFF_TV + (size_t)M * 32 * 2;
constexpr size_t OFF_RK = OFF_DT + (size_t)M * 32 * 4;
constexpr size_t OFF_XCTX = OFF_RK + (size_t)M * 32 * 4;
constexpr size_t OFF_MOD = OFF_XCTX + (size_t)NB * CL * D * 4;
constexpr size_t OFF_ROPE = OFF_MOD + (size_t)4 * 5 * 9216 * 4;
constexpr size_t OFF_BAR = OFF_ROPE + (size_t)128 * 16 * 2 * 4;
constexpr size_t OFF_CENSUS = OFF_BAR + 16384;
constexpr size_t WS_NEED = OFF_CENSUS + 16384;

constexpr size_t W_FIN0 = 0, W_FOUT0 = 5767168, W_FIN1 = 8650752, W_FOUT1 = 14417920, W_MIX = 17301504;
constexpr size_t W_EIN = W_MIX, W_EOUT = W_MIX + 6029312;
constexpr size_t W_R = W_MIX, W_K = W_R + 1048576, W_V = W_K + 1048576, W_O = W_V + 1048576, W_W1 = W_O + 1048576,
                 W_A1 = W_W1 + 131072, W_G1 = W_A1 + 131072, W_V1 = W_G1 + 163840, W_G2 = W_V1 + 32768, W_V2 = W_G2 + 163840;

struct Params {
  const float* in[40];
  float* xlat;
  char* ws;
};

enum { I_X = 0, I_C, I_CTX, I_CCTX, I_ADAW, I_ADAB, I_NORMW, I_FWIN, I_FWOUT, I_EWIN, I_EWOUT, I_LAMBDA, I_SUBLN, I_CONVW, I_CONVB,
       I_DTBIAS, I_ALOG, I_SSDD, I_SSDNORM, I_MU, I_WR, I_WK, I_WV, I_WO, I_W0, I_W1, I_W2, I_A0, I_A1, I_A2, I_G1, I_G2,
       I_KK, I_KA, I_RK, I_LNW, I_LNB, I_V0, I_V1, I_V2 };

DI const void* rfl_ptr(const void* p) {
  unsigned lo = (unsigned)(size_t)p, hi = (unsigned)((size_t)p >> 32);
  lo = __builtin_amdgcn_readfirstlane(lo); hi = __builtin_amdgcn_readfirstlane(hi);
  return (const void*)(__attribute__((address_space(1))) const char*)(((size_t)hi << 32) | (size_t)lo);
}
#define IN(i) ((const float*)rfl_ptr((const void*)P.in[i]))
#define WSP ((char*)rfl_ptr((const void*)P.ws))
#define XLATP ((float*)rfl_ptr((const void*)P.xlat))
DI int ltid() { int t = threadIdx.x; asm volatile("" : "+v"(t)); return t; }
DI int lbid() { int t = blockIdx.x; asm volatile("" : "+s"(t)); return t; }
DI bf16 f2bf(float x) { __bf16 r = (__bf16)x; return __builtin_bit_cast(unsigned short, r); }
DI float bf2f(bf16 v) { return __uint_as_float(((unsigned)v) << 16); }
DI float siluf(float x) { return x / (1.f + __expf(-x)); }
DI float sigmoidf(float x) { return 1.f / (1.f + __expf(-x)); }
DI float softplusf(float x) { return x > 20.f ? x : log1pf(expf(x)); }
template <int CTRL> DI float dppf(float v) { return __int_as_float(__builtin_amdgcn_update_dpp(0, __float_as_int(v), CTRL, 0xf, 0xf, false)); }
DI float red4(float v) { v += dppf<0xB1>(v); v += dppf<0x4E>(v); return v; }
DI float red8(float v) { v = red4(v); v += dppf<0x141>(v); return v; }
DI float red16(float v) { v = red8(v); v += dppf<0x128>(v); return v; }
DI float wave_sum(float v) {
#pragma unroll
  for (int o = 32; o >= 1; o >>= 1) v += __shfl_xor(v, o);
  return v;
}
DI float* xrow(const Params& P, int g) {
  int b = g / TB, p = g - b * TB;
  return p < CL ? (float*)(WSP + OFF_XCTX) + ((size_t)(b * CL + p)) * D : XLATP + ((size_t)b * 8192 + (p - CL)) * D;
}
#define MFMA16(a, b, c) __builtin_amdgcn_mfma_f32_16x16x32_bf16((a), (b), (c), 0, 0, 0)

DI void phase_init(const Params& P, char* smem) {
  const int tid = ltid(), lane = tid & 63, wave = tid >> 6;
  float* sil = (float*)smem;
  float* red = sil + 5 * 1024;
  const float* c = IN(I_C);
  const float* cc = IN(I_CCTX);
  for (int i = tid; i < 5 * 1024; i += 256) {
    int r = i >> 10, k = i & 1023;
    float x = r < 4 ? c[r * 1024 + k] : cc[k];
    sil[i] = x / (1.f + expf(-x));
  }
  __syncthreads();
  float* mod = (float*)(WSP + OFF_MOD);
  for (int item = lbid(); item < 576; item += gridDim.x) {
    int l = item / 144, n = (item % 144) * 64 + lane;
    const float* w = IN(I_ADAW) + (size_t)l * 1024 * 9216 + n;
    float a0 = 0.f, a1 = 0.f, a2 = 0.f, a3 = 0.f, a4 = 0.f;
#pragma unroll 8
    for (int k = wave * 256; k < wave * 256 + 256; ++k) {
      float wv = w[(size_t)k * 9216];
      a0 += sil[k] * wv; a1 += sil[1024 + k] * wv; a2 += sil[2048 + k] * wv; a3 += sil[3072 + k] * wv; a4 += sil[4096 + k] * wv;
    }
    red[(wave * 5 + 0) * 64 + lane] = a0; red[(wave * 5 + 1) * 64 + lane] = a1; red[(wave * 5 + 2) * 64 + lane] = a2;
    red[(wave * 5 + 3) * 64 + lane] = a3; red[(wave * 5 + 4) * 64 + lane] = a4;
    __syncthreads();
    if (wave == 0) {
      float bias = IN(I_ADAB)[l * 9216 + n];
#pragma unroll
      for (int r = 0; r < 5; ++r) {
        float s = red[r * 64 + lane] + red[(5 + r) * 64 + lane] + red[(10 + r) * 64 + lane] + red[(15 + r) * 64 + lane] + bias;
        mod[((size_t)(l * 5 + r)) * 9216 + n] = s;
      }
    }
    __syncthreads();
  }
  if (lbid() == 0) {
    float* cosT = (float*)(WSP + OFF_ROPE);
    float* sinT = cosT + 2048;
    for (int i = tid; i < 2048; i += 256) {
      int pos = i >> 4, f = i & 15;
      float inv = powf(10000.f, -(float)f / 16.f);
      float ang = (float)pos * inv;
      cosT[i] = cosf(ang); sinT[i] = sinf(ang);
    }
  }
  const size_t gt = (size_t)lbid() * 256 + tid, gn = (size_t)gridDim.x * 256;
  const float4* xs = (const float4*)IN(I_X);
  float4* xd = (float4*)XLATP;
  for (size_t i = gt; i < (size_t)NB * 8192 * D / 4; i += gn) xd[i] = xs[i];
  const float4* cs = (const float4*)IN(I_CTX);
  float4* cd = (float4*)(WSP + OFF_XCTX);
  for (size_t i = gt; i < (size_t)NB * CL * D / 4; i += gn) cd[i] = cs[i];
}

DI void conv_job(const float* src, int ld, int K, int Nsrc, int Ndst, bf16* dst, int mapmode, int cbid, int cnb) {
  const size_t gt = (size_t)cbid * 256 + ltid(), gn = (size_t)cnb * 256;
  const size_t total = (size_t)Ndst * (K / 8);
  for (size_t id = gt; id < total; id += gn) {
    int n = (int)(id % Ndst), kc = (int)(id / Ndst);
    int col = n;
    if (mapmode == 1) { int j = 16 * (n >> 5) + (n & 15); col = ((n >> 4) & 1) ? FH + j : j; }
    bf16x8 o;
    if (n < Nsrc) {
      const float* s = src + (size_t)(kc * 8) * ld + col;
#pragma unroll
      for (int jj = 0; jj < 8; ++jj) o[jj] = (short)f2bf(s[(size_t)jj * ld]);
    } else {
#pragma unroll
      for (int jj = 0; jj < 8; ++jj) o[jj] = 0;
    }
    *(bf16x8*)(dst + (size_t)n * K + kc * 8) = o;
  }
}

DI void phase_convert(const Params& P, int l, int cbid, int cnb) {
  bf16* W = (bf16*)(WSP + OFF_W) + (size_t)(l & 1) * W_STRIDE;
  conv_job(IN(I_FWIN) + (size_t)(l * 2 + 0) * 1024 * 5632, 5632, 1024, 5632, 5632, W + W_FIN0, 1, cbid, cnb);
  conv_job(IN(I_FWOUT) + (size_t)(l * 2 + 0) * FH * 1024, 1024, FH, 1024, 1024, W + W_FOUT0, 0, cbid, cnb);
  conv_job(IN(I_FWIN) + (size_t)(l * 2 + 1) * 1024 * 5632, 5632, 1024, 5632, 5632, W + W_FIN1, 1, cbid, cnb);
  conv_job(IN(I_FWOUT) + (size_t)(l * 2 + 1) * FH * 1024, 1024, FH, 1024, 1024, W + W_FOUT1, 0, cbid, cnb);
  const int j = l >> 1;
  if ((l & 1) == 0) {
    conv_job(IN(I_EWIN) + (size_t)j * 1024 * 5664, 5664, 1024, 5664, 5888, W + W_EIN, 0, cbid, cnb);
    conv_job(IN(I_EWOUT) + (size_t)j * 2048 * 1024, 1024, 2048, 1024, 1024, W + W_EOUT, 0, cbid, cnb);
  } else {
    conv_job(IN(I_WR) + (size_t)j * 1048576, 1024, 1024, 1024, 1024, W + W_R, 0, cbid, cnb);
    conv_job(IN(I_WK) + (size_t)j * 1048576, 1024, 1024, 1024, 1024, W + W_K, 0, cbid, cnb);
    conv_job(IN(I_WV) + (size_t)j * 1048576, 1024, 1024, 1024, 1024, W + W_V, 0, cbid, cnb);
    conv_job(IN(I_WO) + (size_t)j * 1048576, 1024, 1024, 1024, 1024, W + W_O, 0, cbid, cnb);
    for (int e = 0; e < 2; ++e) {
      conv_job(IN(I_W1) + (size_t)(j * 2 + e) * 65536, 64, 1024, 64, 64, W + W_W1 + e * 65536, 0, cbid, cnb);
      conv_job(IN(I_A1) + (size_t)(j * 2 + e) * 65536, 64, 1024, 64, 64, W + W_A1 + e * 65536, 0, cbid, cnb);
    }
    conv_job(IN(I_G1) + (size_t)j * 163840, 160, 1024, 160, 160, W + W_G1, 0, cbid, cnb);
    conv_job(IN(I_G2) + (size_t)j * 163840, 1024, 160, 1024, 1024, W + W_G2, 0, cbid, cnb);
    if (j > 0) {
      conv_job(IN(I_V1) + (size_t)(j - 1) * 32768, 32, 1024, 32, 32, W + W_V1, 0, cbid, cnb);
      conv_job(IN(I_V2) + (size_t)(j - 1) * 32768, 1024, 32, 1024, 1024, W + W_V2, 0, cbid, cnb);
    }
  }
}

DI void phase_postpre(const Params& P, bool do_post, int lpost, int spost, float wgt, bool do_pre, int lpre, int spre) {
  const int lane = ltid() & 63;
  const int gw = lbid() * 4 + (ltid() >> 6), nw = gridDim.x * 4;
  const float* mod = (const float*)(WSP + OFF_MOD);
  const bf16* Y = (const bf16*)(WSP + OFF_Y);
  bf16* H = (bf16*)(WSP + OFF_H);
  for (int g = gw; g < M; g += nw) {
    const int b = g / TB, p = g - b * TB, r5 = p < CL ? 4 : b;
    float* x = xrow(P, g);
    float4 xq[4], gq[4], nq[4], shq[4], scq[4], npq[4];
    bf16x4 yq[4];
#pragma unroll
    for (int i = 0; i < 4; ++i) xq[i] = *(const float4*)(x + i * 256 + lane * 4);
    if (do_post) {
      const float* gate = mod + ((size_t)(lpost * 5 + r5) * 9 + 3 * spost + 2) * 1024;
      const float* nwp = IN(I_NORMW) + (size_t)(lpost * 6 + 2 * spost + 1) * 1024;
#pragma unroll
      for (int i = 0; i < 4; ++i) {
        yq[i] = *(const bf16x4*)(Y + (size_t)g * D + i * 256 + lane * 4);
        gq[i] = *(const float4*)(gate + i * 256 + lane * 4);
        nq[i] = *(const float4*)(nwp + i * 256 + lane * 4);
      }
    }
    if (do_pre) {
      const float* shift = mod + ((size_t)(lpre * 5 + r5) * 9 + 3 * spre) * 1024;
      const float* nwp = IN(I_NORMW) + (size_t)(lpre * 6 + 2 * spre) * 1024;
#pragma unroll
      for (int i = 0; i < 4; ++i) {
        shq[i] = *(const float4*)(shift + i * 256 + lane * 4);
        scq[i] = *(const float4*)(shift + 1024 + i * 256 + lane * 4);
        npq[i] = *(const float4*)(nwp + i * 256 + lane * 4);
      }
    }
    float xv[16];
#pragma unroll
    for (int i = 0; i < 4; ++i) { xv[4 * i] = xq[i].x; xv[4 * i + 1] = xq[i].y; xv[4 * i + 2] = xq[i].z; xv[4 * i + 3] = xq[i].w; }
    if (do_post) {
      float yv[16]; float ss = 0.f;
#pragma unroll
      for (int i = 0; i < 4; ++i)
#pragma unroll
        for (int e = 0; e < 4; ++e) { const float v = bf2f((bf16)yq[i][e]); yv[4 * i + e] = v; ss += v * v; }
      ss = wave_sum(ss);
      const float rs = rsqrtf(ss * (1.f / 1024.f) + 1e-6f);
#pragma unroll
      for (int i = 0; i < 4; ++i) {
        xv[4 * i] += wgt * gq[i].x * (yv[4 * i] * rs * nq[i].x);
        xv[4 * i + 1] += wgt * gq[i].y * (yv[4 * i + 1] * rs * nq[i].y);
        xv[4 * i + 2] += wgt * gq[i].z * (yv[4 * i + 2] * rs * nq[i].z);
        xv[4 * i + 3] += wgt * gq[i].w * (yv[4 * i + 3] * rs * nq[i].w);
      }
#pragma unroll
      for (int i = 0; i < 4; ++i) *(float4*)(x + i * 256 + lane * 4) = make_float4(xv[4 * i], xv[4 * i + 1], xv[4 * i + 2], xv[4 * i + 3]);
    }
    if (do_pre) {
      float ss = 0.f;
#pragma unroll
      for (int i = 0; i < 16; ++i) ss += xv[i] * xv[i];
      ss = wave_sum(ss);
      const float rs = rsqrtf(ss * (1.f / 1024.f) + 1e-6f);
#pragma unroll
      for (int i = 0; i < 4; ++i) {
        bf16x4 o;
        o[0] = (short)f2bf(xv[4 * i] * rs * npq[i].x * (1.f + scq[i].x) + shq[i].x);
        o[1] = (short)f2bf(xv[4 * i + 1] * rs * npq[i].y * (1.f + scq[i].y) + shq[i].y);
        o[2] = (short)f2bf(xv[4 * i + 2] * rs * npq[i].z * (1.f + scq[i].z) + shq[i].z);
        o[3] = (short)f2bf(xv[4 * i + 3] * rs * npq[i].w * (1.f + scq[i].w) + shq[i].w);
        *(bf16x4*)(H + (size_t)g * D + i * 256 + lane * 4) = o;
      }
    }
  }
}

struct GA {
  const bf16* A; const bf16* A2; int lda; int ksplit;
  const float* mu;
  const bf16* Wt; int K; int N;
  bf16* o0; bf16* o1; int ldc; int act;
  const float* f0;
};
enum { EPI_STORE = 0, EPI_SWIGLU = 1, EPI_EVENIN = 2, EPI_VMIX = 3, EPI_GMUL = 4 };

template <int EPI, int WN>
DI void gemm_epilogue(const Params& P, const GA& g, int m0, int n0, int wm, int wn, int l15, int Q, f32x4 (&acc)[4][WN]) {
  const int wc0 = n0 + wn * (16 * WN);
  if constexpr (EPI == EPI_STORE) {
#pragma unroll
    for (int mt = 0; mt < 4; ++mt) {
      const size_t row = m0 + wm * 64 + mt * 16 + l15;
#pragma unroll
      for (int nt = 0; nt < WN; ++nt) {
        const int col = wc0 + nt * 16 + 4 * Q;
        if (col < g.N) {
          bf16x4 o;
#pragma unroll
          for (int r = 0; r < 4; ++r) {
            float v = acc[mt][nt][r];
            if (g.act == 1) v = tanhf(v); else if (g.act == 2) v = sigmoidf(v);
            o[r] = (short)f2bf(v);
          }
          *(bf16x4*)(g.o0 + row * g.ldc + col) = o;
          if (g.o1) *(bf16x4*)(g.o1 + row * g.ldc + col) = o;
        }
      }
    }
  } else if constexpr (EPI == EPI_SWIGLU) {
#pragma unroll
    for (int mt = 0; mt < 4; ++mt) {
      const size_t row = m0 + wm * 64 + mt * 16 + l15;
#pragma unroll
      for (int pr = 0; pr < WN / 2; ++pr) {
        const int jcol = (wc0 >> 1) + pr * 16 + 4 * Q;
        bf16x4 o;
#pragma unroll
        for (int r = 0; r < 4; ++r) {
          const float gt = acc[mt][2 * pr][r];
          o[r] = (short)f2bf(gt * __builtin_amdgcn_rcpf(1.f + __expf(-gt)) * acc[mt][2 * pr + 1][r]);
        }
        *(bf16x4*)(g.o0 + row * FH + jcol) = o;
      }
    }
  } else if constexpr (EPI == EPI_EVENIN) {
    bf16* Qb = (bf16*)(WSP + OFF_BIG);
    bf16* Kb = Qb + (size_t)M * D;
    bf16* Vt = Kb + (size_t)M * D;
    bf16* Zb = Vt + (size_t)M * D;
    bf16* BCb = Zb + (size_t)M * D;
    bf16* XS = (bf16*)(WSP + OFF_Y);
    float* DT = (float*)(WSP + OFF_DT);
    if (n0 < 2048) {
      const bool isq = n0 < 1024;
      bf16* dst = isq ? Qb : Kb;
      const float sc = isq ? 0.125f * 1.4426950408889634f : 1.f;
      const float* cosT = (const float*)(WSP + OFF_ROPE);
      const float* sinT = cosT + 2048;
      const int p0 = (m0 + wm * 64) % TB;
      const bool lat = p0 >= CL;
      float cr = 1.f, sr = 0.f, c2v[4][4], s2v[4][4];
#pragma unroll
      for (int mt = 0; mt < 4; ++mt)
#pragma unroll
        for (int r = 0; r < 4; ++r) { c2v[mt][r] = 1.f; s2v[mt][r] = 0.f; }
      if (lat) {
        const int pr = (p0 - CL) >> 6;
        cr = cosT[pr * 16 + l15]; sr = sinT[pr * 16 + l15];
#pragma unroll
        for (int mt = 0; mt < 4; ++mt)
#pragma unroll
          for (int r = 0; r < 4; ++r) { const int pc = mt * 16 + 4 * Q + r; c2v[mt][r] = cosT[pc * 16 + l15]; s2v[mt][r] = sinT[pc * 16 + l15]; }
      }
#pragma unroll
      for (int vs = 0; vs < WN / 4; ++vs) {
        const int cb = (isq ? wc0 : wc0 - 1024) + vs * 64 + l15;
#pragma unroll
        for (int mt = 0; mt < 4; ++mt)
#pragma unroll
          for (int r = 0; r < 4; ++r) {
            const int row = m0 + wm * 64 + mt * 16 + 4 * Q + r;
            const float x1 = acc[mt][4 * vs + 0][r], x2 = acc[mt][4 * vs + 1][r], x3 = acc[mt][4 * vs + 2][r], x4 = acc[mt][4 * vs + 3][r];
            const float c2 = c2v[mt][r], s2 = s2v[mt][r];
            const float o1 = x1 * cr - x2 * sr, o2 = x2 * cr + x1 * sr, o3 = x3 * c2 - x4 * s2, o4 = x4 * c2 + x3 * s2;
            bf16* d = dst + (size_t)row * D + cb;
            d[0] = f2bf(o1 * sc); d[16] = f2bf(o2 * sc); d[32] = f2bf(o3 * sc); d[48] = f2bf(o4 * sc);
          }
      }
    } else if (n0 < 3072) {
      const int b = m0 / TB, pb = m0 - b * TB;
#pragma unroll
      for (int mt = 0; mt < 4; ++mt)
#pragma unroll
        for (int nt = 0; nt < WN; ++nt) {
          const int c = wc0 - 2048 + nt * 16 + l15;
          const int p0 = pb + wm * 64 + mt * 16 + 4 * Q;
          bf16x4 o;
#pragma unroll
          for (int r = 0; r < 4; ++r) o[r] = (short)f2bf(acc[mt][nt][r]);
          *(bf16x4*)(Vt + ((size_t)(b * 1024 + c)) * TB + p0) = o;
        }
    } else if (n0 < 5632) {
      bf16* dst; int ld, cb;
      if (n0 < 4096) { dst = Zb; ld = 1024; cb = wc0 - 3072; }
      else if (n0 < 5120) { dst = XS; ld = 1024; cb = wc0 - 4096; }
      else { dst = BCb; ld = 512; cb = wc0 - 5120; }
#pragma unroll
      for (int mt = 0; mt < 4; ++mt)
#pragma unroll
        for (int nt = 0; nt < WN; ++nt)
#pragma unroll
          for (int r = 0; r < 4; ++r) {
            const size_t row = m0 + wm * 64 + mt * 16 + 4 * Q + r;
            dst[row * ld + cb + nt * 16 + l15] = f2bf(acc[mt][nt][r]);
          }
    } else {
#pragma unroll
      for (int mt = 0; mt < 4; ++mt)
#pragma unroll
        for (int nt = 0; nt < WN; ++nt) {
          const int col = wc0 - 5632 + nt * 16 + l15;
          if (col < 32) {
#pragma unroll
            for (int r = 0; r < 4; ++r) {
              const size_t row = m0 + wm * 64 + mt * 16 + 4 * Q + r;
              DT[row * 32 + col] = acc[mt][nt][r];
            }
          }
        }
    }
  } else if constexpr (EPI == EPI_VMIX) {
    const bf16* VF = (const bf16*)(WSP + OFF_VF);
#pragma unroll
    for (int mt = 0; mt < 4; ++mt) {
      const size_t rb = (size_t)(m0 + wm * 64 + mt * 16 + l15) * D + wc0 + 4 * Q;
      bf16x4 ov[WN], of[WN];
      float4 v0[WN];
#pragma unroll
      for (int nt = 0; nt < WN; ++nt) {
        ov[nt] = *(const bf16x4*)(g.o0 + rb + nt * 16);
        of[nt] = *(const bf16x4*)(VF + rb + nt * 16);
        v0[nt] = *(const float4*)(g.f0 + wc0 + nt * 16 + 4 * Q);
      }
#pragma unroll
      for (int nt = 0; nt < WN; ++nt) {
        const float vz[4] = {v0[nt].x, v0[nt].y, v0[nt].z, v0[nt].w};
        bf16x4 o;
#pragma unroll
        for (int r = 0; r < 4; ++r) {
          const float v = bf2f((bf16)ov[nt][r]), vf = bf2f((bf16)of[nt][r]);
          o[r] = (short)f2bf(v + (vf - v) * sigmoidf(vz[r] + acc[mt][nt][r]));
        }
        *(bf16x4*)(g.o0 + rb + nt * 16) = o;
      }
    }
  } else if constexpr (EPI == EPI_GMUL) {
#pragma unroll
    for (int mt = 0; mt < 4; ++mt) {
      const size_t rb = (size_t)(m0 + wm * 64 + mt * 16 + l15) * D + wc0 + 4 * Q;
      bf16x4 ov[WN];
#pragma unroll
      for (int nt = 0; nt < WN; ++nt) ov[nt] = *(const bf16x4*)(g.o0 + rb + nt * 16);
#pragma unroll
      for (int nt = 0; nt < WN; ++nt) {
        bf16x4 o;
#pragma unroll
        for (int r = 0; r < 4; ++r) o[r] = (short)f2bf(bf2f((bf16)ov[nt][r]) * acc[mt][nt][r]);
        *(bf16x4*)(g.o0 + rb + nt * 16) = o;
      }
    }
  }
}

template <int BK, int AMODE, int EPI, int WN>
DI void gemm_phase(const Params& P, const GA& g, char* smem) {
  constexpr int LS = BK;
  constexpr int CPR = BK / 8;
  constexpr int BN = 32 * WN;
  constexpr int NCHA = 128 * CPR / 256, NCHB = BN * CPR / 256;
  constexpr int RSTEP = 256 / CPR;
  constexpr int BUF = (128 + BN) * LS;
  constexpr int GW = 8;
#define SWZ(row, c) ((BK == 64) ? ((c) ^ (((row) >> 1) & 7)) : ((c) ^ ((4 - (((row) >> 2) & 3)) & 3)))
  bf16* S0 = (bf16*)smem;
  const int tid = ltid(), lane = tid & 63, wave = tid >> 6, wm = wave >> 1, wn = wave & 1, l15 = lane & 15, Q = lane >> 4;
  const int ntn = (g.N + BN - 1) / BN, ntiles = (M / 128) * ntn;
  const int nk = g.K / BK;
  const int crow = tid / CPR, ckc = tid - crow * CPR;
  for (int tile = lbid(); tile < ntiles; tile += gridDim.x) {
    int tmi, tni;
    {
      const int x = tile & 7, i = tile >> 3, nfull = ntn / GW, rem = ntn - nfull * GW;
      if (i < nfull * (33 * GW)) { const int g8 = i / (33 * GW), ii = i - g8 * (33 * GW); tni = g8 * GW + (ii % GW); tmi = x * 33 + ii / GW; }
      else { const int ii = i - nfull * (33 * GW); tni = nfull * GW + ii % rem; tmi = x * 33 + ii / rem; }
    }
    const int m0 = tmi * 128, n0 = tni * BN;
    f32x4 acc[4][WN];
#pragma unroll
    for (int i = 0; i < 4; ++i)
#pragma unroll
      for (int j = 0; j < WN; ++j) acc[i][j] = f32x4{0.f, 0.f, 0.f, 0.f};
    struct RS { bf16x8 ra[NCHA], rb[NCHB], rp[AMODE ? NCHA : 1], rn[AMODE ? NCHA : 1]; float muv[AMODE ? 8 : 1]; };
    RS s0, s1;
    auto load_tiles = [&](RS& s, int kt) {
      const int k = kt * BK + ckc * 8;
#pragma unroll
      for (int i = 0; i < NCHA; ++i) {
        const int row = crow + i * RSTEP;
        const size_t gi = (size_t)(m0 + row);
        if constexpr (AMODE == 0) {
          const bf16* src = (g.A2 != nullptr && k >= g.ksplit) ? g.A2 + gi * g.lda + (k - g.ksplit) : g.A + gi * g.lda + k;
          s.ra[i] = *(const bf16x8*)src;
        } else {
          const int p = (int)(gi % TB);
          const bool hp = (p != 0) && (p != CL), hn = (p != CL - 1) && (p != TB - 1);
          const bf16* src = g.A + gi * g.lda + k;
          s.ra[i] = *(const bf16x8*)src;
          s.rp[i] = hp ? *(const bf16x8*)(src - g.lda) : bf16x8{0, 0, 0, 0, 0, 0, 0, 0};
          s.rn[i] = hn ? *(const bf16x8*)(src + g.lda) : bf16x8{0, 0, 0, 0, 0, 0, 0, 0};
        }
      }
#pragma unroll
      for (int i = 0; i < NCHB; ++i) {
        const int n = n0 + crow + i * RSTEP;
        if (n < g.N) s.rb[i] = *(const bf16x8*)(g.Wt + (size_t)n * g.K + k);
        else s.rb[i] = bf16x8{0, 0, 0, 0, 0, 0, 0, 0};
      }
      if constexpr (AMODE == 1) {
        const float4 m0v = *(const float4*)(g.mu + k), m1v = *(const float4*)(g.mu + k + 4);
        s.muv[0] = m0v.x; s.muv[1] = m0v.y; s.muv[2] = m0v.z; s.muv[3] = m0v.w; s.muv[4] = m1v.x; s.muv[5] = m1v.y; s.muv[6] = m1v.z; s.muv[7] = m1v.w;
      }
    };
    auto store_tiles = [&](const RS& s, int buf) {
      bf16* As = S0 + buf * BUF;
      bf16* Bs = As + 128 * LS;
#pragma unroll
      for (int i = 0; i < NCHA; ++i) {
        const int row = crow + i * RSTEP;
        if constexpr (AMODE == 0) {
          *(bf16x8*)(As + row * LS + SWZ(row, ckc) * 8) = s.ra[i];
        } else {
          bf16x8 o;
#pragma unroll
          for (int e = 0; e < 8; ++e) {
            const float hv = bf2f((bf16)s.ra[i][e]);
            const float pv = bf2f((bf16)s.rp[i][e]), nv = bf2f((bf16)s.rn[i][e]);
            o[e] = (short)f2bf(hv + (0.5f * (pv + nv) - hv) * s.muv[e]);
          }
          *(bf16x8*)(As + row * LS + SWZ(row, ckc) * 8) = o;
        }
      }
#pragma unroll
      for (int i = 0; i < NCHB; ++i) *(bf16x8*)(Bs + (crow + i * RSTEP) * LS + SWZ(crow + i * RSTEP, ckc) * 8) = s.rb[i];
    };
    auto compute = [&](int buf) {
      __builtin_amdgcn_s_setprio(1);
      const bf16* As = S0 + buf * BUF;
      const bf16* Bs = As + 128 * LS;
#pragma unroll
      for (int ks = 0; ks < BK / 32; ++ks) {
        bf16x8 af[4], bfr[WN];
#pragma unroll
        for (int t = 0; t < 4; ++t) af[t] = *(const bf16x8*)(As + (wm * 64 + t * 16 + l15) * LS + SWZ(l15, ks * 4 + Q) * 8);
#pragma unroll
        for (int t = 0; t < WN; ++t) bfr[t] = *(const bf16x8*)(Bs + (wn * (16 * WN) + t * 16 + l15) * LS + SWZ(l15, ks * 4 + Q) * 8);
#pragma unroll
        for (int mt = 0; mt < 4; ++mt)
#pragma unroll
          for (int nt = 0; nt < WN; ++nt) {
            if constexpr (EPI != EPI_EVENIN) acc[mt][nt] = MFMA16(bfr[nt], af[mt], acc[mt][nt]);
            else acc[mt][nt] = MFMA16(af[mt], bfr[nt], acc[mt][nt]);
          }
      }
      __builtin_amdgcn_s_setprio(0);
    };
    __syncthreads();
    load_tiles(s0, 0);
    store_tiles(s0, 0);
    if constexpr (AMODE == 0 && WN == 4) {
      if (nk > 1) load_tiles(s0, 1);
      __syncthreads();
      for (int kt = 0; kt < nk; kt += 2) {
        if (kt + 2 < nk) load_tiles(s1, kt + 2);
        compute(0);
        if (kt + 1 < nk) store_tiles(s0, 1);
        __syncthreads();
        if (kt + 1 < nk) {
          if (kt + 3 < nk) load_tiles(s0, kt + 3);
          compute(1);
          if (kt + 2 < nk) store_tiles(s1, 0);
          __syncthreads();
        }
      }
    } else {
      __syncthreads();
      for (int kt = 0; kt < nk; ++kt) {
        if (kt + 1 < nk) load_tiles(s0, kt + 1);
        compute(kt & 1);
        if (kt + 1 < nk) store_tiles(s0, (kt + 1) & 1);
        __syncthreads();
      }
    }
    gemm_epilogue<EPI, WN>(P, g, m0, n0, wm, wn, l15, Q, acc);
  }
}

DI GA make_ga(const bf16* A, int lda, const bf16* Wt, int K, int N, bf16* o0, int ldc) {
  GA g; g.A = A; g.A2 = nullptr; g.lda = lda; g.ksplit = 0; g.mu = nullptr; g.Wt = Wt; g.K = K; g.N = N; g.o0 = o0; g.o1 = nullptr; g.ldc = ldc; g.act = 0; g.f0 = nullptr;
  return g;
}

DI void phase_attn(const Params& P, int j, int layer, char* smem, bool dry) {
  bf16* Qb = (bf16*)(WSP + OFF_BIG);
  const bf16* Kb = Qb + (size_t)M * D;
  const bf16* Vt = Kb + (size_t)M * D;
  constexpr int KBYTES = 64 * 272, VBYTES = 128 * 144, STAGE = KBYTES + VBYTES;
  const int tid = ltid(), lane = tid & 63, wave = tid >> 6, l15 = lane & 15, Q = lane >> 4;
  const float lam_init = 0.8f - 0.6f * expf(-0.3f * (float)layer);
  float lam;
  {
    const float* lp = IN(I_LAMBDA) + j * 256;
    float s1 = 0.f, s2 = 0.f;
    for (int i = 0; i < 64; ++i) { s1 += lp[i] * lp[64 + i]; s2 += lp[128 + i] * lp[192 + i]; }
    lam = expf(s1) - expf(s2) + lam_init;
  }
  const float* subln = IN(I_SUBLN) + j * 128;
  const int nitems = 2048 + 64;
  const int krow = tid >> 4, kc16 = tid & 15, vrow = tid >> 3, vc = tid & 7;
  for (int item = lbid(); item < nitems; item += gridDim.x) {
    int b, h, q0, nkv;
    if (item < 2048) {
      const int x = item & 7, i = item >> 3, pair = x * 4 + (i >> 6);
      b = pair >> 3; h = pair & 7; q0 = CL + (i & 63) * 128; nkv = 132;
    } else { const int it = item - 2048; b = it >> 4; h = (it >> 1) & 7; q0 = (it & 1) * 128; nkv = 4; }
    const size_t gb = (size_t)b * TB;
    const bf16* Kbase = Kb + gb * D + h * 128 + kc16 * 8;
    const bf16* Vbase = Vt + ((size_t)(b * 1024 + h * 128)) * TB + vc * 8;
    bf16x8 Qf[2][2][2];
#pragma unroll
    for (int qt = 0; qt < 2; ++qt)
#pragma unroll
      for (int m = 0; m < 2; ++m)
#pragma unroll
        for (int ks = 0; ks < 2; ++ks)
          Qf[qt][m][ks] = *(const bf16x8*)(Qb + (gb + q0 + wave * 32 + qt * 16 + l15) * D + h * 128 + m * 64 + ks * 32 + Q * 8);
    float mrun[2][2], lrun[2][2];
#pragma unroll
    for (int qt = 0; qt < 2; ++qt)
#pragma unroll
      for (int m = 0; m < 2; ++m) { mrun[qt][m] = 0.f; lrun[qt][m] = 0.f; }
    bf16x8 pk[4], pv[4];
    __syncthreads();
#pragma unroll
    for (int i = 0; i < 4; ++i) pk[i] = *(const bf16x8*)(Kbase + (size_t)(krow + 16 * i) * D);
#pragma unroll
    for (int i = 0; i < 4; ++i) *(bf16x8*)(smem + (krow + 16 * i) * 272 + kc16 * 16) = pk[i];
    __syncthreads();
#pragma unroll
    for (int m = 0; m < 2; ++m) {
      float mx0 = -3.0e38f, mx1 = -3.0e38f;
#pragma unroll
      for (int kt = 0; kt < 4; ++kt) {
        const bf16x8 k0 = *(const bf16x8*)(smem + (kt * 16 + l15) * 272 + (m * 64 + Q * 8) * 2);
        const bf16x8 k1 = *(const bf16x8*)(smem + (kt * 16 + l15) * 272 + (m * 64 + 32 + Q * 8) * 2);
        f32x4 t0 = f32x4{0.f, 0.f, 0.f, 0.f}, t1 = f32x4{0.f, 0.f, 0.f, 0.f};
        t0 = MFMA16(k0, Qf[0][m][0], t0); t0 = MFMA16(k1, Qf[0][m][1], t0);
        t1 = MFMA16(k0, Qf[1][m][0], t1); t1 = MFMA16(k1, Qf[1][m][1], t1);
        mx0 = fmaxf(fmaxf(mx0, fmaxf(t0[0], t0[1])), fmaxf(t0[2], t0[3]));
        mx1 = fmaxf(fmaxf(mx1, fmaxf(t1[0], t1[1])), fmaxf(t1[2], t1[3]));
      }
      mrun[0][m] = mx0 + 32.f; mrun[1][m] = mx1 + 32.f;
    }
    for (int kv = 0; kv < nkv; ++kv) {
      if (kv + 1 < nkv) {
#pragma unroll
        for (int i = 0; i < 4; ++i) pk[i] = *(const bf16x8*)(Kbase + (size_t)((kv + 1) * 64 + krow + 16 * i) * D);
      }
      const char* sK = smem + (kv & 1) * STAGE;
#pragma unroll
      for (int m = 0; m < 2; ++m) {
#pragma unroll
        for (int kt = 0; kt < 4; ++kt) {
          const bf16x8 k0 = *(const bf16x8*)(sK + (kt * 16 + l15) * 272 + (m * 64 + Q * 8) * 2);
          const bf16x8 k1 = *(const bf16x8*)(sK + (kt * 16 + l15) * 272 + (m * 64 + 32 + Q * 8) * 2);
#pragma unroll
          for (int qt = 0; qt < 2; ++qt) {
            const float nb = -mrun[qt][m];
            f32x4 t = f32x4{nb, nb, nb, nb};
            t = MFMA16(k0, Qf[qt][m][0], t);
            t = MFMA16(k1, Qf[qt][m][1], t);
            lrun[qt][m] += (__builtin_amdgcn_exp2f(t[0]) + __builtin_amdgcn_exp2f(t[1])) + (__builtin_amdgcn_exp2f(t[2]) + __builtin_amdgcn_exp2f(t[3]));
          }
        }
      }
      if (kv + 1 < nkv) {
        char* dK = smem + ((kv + 1) & 1) * STAGE;
#pragma unroll
        for (int i = 0; i < 4; ++i) *(bf16x8*)(dK + (krow + 16 * i) * 272 + kc16 * 16) = pk[i];
      }
      __syncthreads();
    }
    float Mx[2][2];
#pragma unroll
    for (int qt = 0; qt < 2; ++qt)
#pragma unroll
      for (int m = 0; m < 2; ++m) {
        float mm = mrun[qt][m], ll = lrun[qt][m];
#pragma unroll
        for (int o = 16; o <= 32; o <<= 1) {
          const float mo = __shfl_xor(mm, o), lo = __shfl_xor(ll, o);
          const float mn = fmaxf(mm, mo);
          ll = ll * __builtin_amdgcn_exp2f(mm - mn) + lo * __builtin_amdgcn_exp2f(mo - mn);
          mm = mn;
        }
        Mx[qt][m] = mm + __log2f(ll);
      }
    f32x4 O[2][8];
#pragma unroll
    for (int qt = 0; qt < 2; ++qt)
#pragma unroll
      for (int t = 0; t < 8; ++t) O[qt][t] = f32x4{0.f, 0.f, 0.f, 0.f};
#pragma unroll
    for (int i = 0; i < 4; ++i) {
      pk[i] = *(const bf16x8*)(Kbase + (size_t)(krow + 16 * i) * D);
      pv[i] = *(const bf16x8*)(Vbase + (size_t)(vrow + 32 * i) * TB);
    }
#pragma unroll
    for (int i = 0; i < 4; ++i) {
      *(bf16x8*)(smem + (krow + 16 * i) * 272 + kc16 * 16) = pk[i];
      *(bf16x8*)(smem + KBYTES + (vrow + 32 * i) * 144 + vc * 16) = pv[i];
    }
    __syncthreads();
    for (int kv = 0; kv < nkv; ++kv) {
      if (kv + 1 < nkv) {
#pragma unroll
        for (int i = 0; i < 4; ++i) {
          pk[i] = *(const bf16x8*)(Kbase + (size_t)((kv + 1) * 64 + krow + 16 * i) * D);
          pv[i] = *(const bf16x8*)(Vbase + (size_t)(vrow + 32 * i) * TB + (kv + 1) * 64);
        }
      }
      const char* sK = smem + (kv & 1) * STAGE;
      const char* sV = sK + KBYTES;
#pragma unroll
      for (int ks2 = 0; ks2 < 2; ++ks2) {
        bf16x8 Pf[2];
#pragma unroll
        for (int half = 0; half < 2; ++half) {
          const int kt = ks2 * 2 + half;
          f32x4 s[2][2];
#pragma unroll
          for (int m = 0; m < 2; ++m) {
            const bf16x8 k0 = *(const bf16x8*)(sK + (kt * 16 + l15) * 272 + (m * 64 + Q * 8) * 2);
            const bf16x8 k1 = *(const bf16x8*)(sK + (kt * 16 + l15) * 272 + (m * 64 + 32 + Q * 8) * 2);
#pragma unroll
            for (int qt = 0; qt < 2; ++qt) {
              const float nm = -Mx[qt][m];
              f32x4 t = f32x4{nm, nm, nm, nm};
              t = MFMA16(k0, Qf[qt][m][0], t);
              t = MFMA16(k1, Qf[qt][m][1], t);
              s[qt][m] = t;
            }
          }
#pragma unroll
          for (int qt = 0; qt < 2; ++qt)
#pragma unroll
            for (int r = 0; r < 4; ++r) {
              const float a = __builtin_amdgcn_exp2f(s[qt][0][r]) - lam * __builtin_amdgcn_exp2f(s[qt][1][r]);
              Pf[qt][half * 4 + r] = (short)f2bf(a);
            }
        }
        __builtin_amdgcn_s_setprio(1);
#pragma unroll
        for (int t = 0; t < 8; ++t) {
          const bf16x4 v0 = *(const bf16x4*)(sV + (t * 16 + l15) * 144 + (ks2 * 32 + Q * 4) * 2);
          const bf16x4 v1 = *(const bf16x4*)(sV + (t * 16 + l15) * 144 + (ks2 * 32 + 16 + Q * 4) * 2);
          const bf16x8 vf = __builtin_shufflevector(v0, v1, 0, 1, 2, 3, 4, 5, 6, 7);
#pragma unroll
          for (int qt = 0; qt < 2; ++qt) O[qt][t] = MFMA16(vf, Pf[qt], O[qt][t]);
        }
        __builtin_amdgcn_s_setprio(0);
      }
      if (kv + 1 < nkv) {
        char* dK = smem + ((kv + 1) & 1) * STAGE;
#pragma unroll
        for (int i = 0; i < 4; ++i) {
          *(bf16x8*)(dK + (krow + 16 * i) * 272 + kc16 * 16) = pk[i];
          *(bf16x8*)(dK + KBYTES + (vrow + 32 * i) * 144 + vc * 16) = pv[i];
        }
      }
      __syncthreads();
    }
    if (!dry) {
#pragma unroll
      for (int qt = 0; qt < 2; ++qt) {
        float ss = 0.f;
#pragma unroll
        for (int t = 0; t < 8; ++t)
#pragma unroll
          for (int r = 0; r < 4; ++r) ss += O[qt][t][r] * O[qt][t][r];
        ss += __shfl_xor(ss, 16);
        ss += __shfl_xor(ss, 32);
        const float rs = rsqrtf(ss * (1.f / 128.f) + 1e-5f) * (1.f - lam_init);
        bf16* dst = Qb + (gb + q0 + wave * 32 + qt * 16 + l15) * D + h * 128;
#pragma unroll
        for (int t = 0; t < 8; ++t) {
          const float4 sw = *(const float4*)(subln + t * 16 + Q * 4);
          bf16x4 o;
          o[0] = (short)f2bf(O[qt][t][0] * rs * sw.x); o[1] = (short)f2bf(O[qt][t][1] * rs * sw.y);
          o[2] = (short)f2bf(O[qt][t][2] * rs * sw.z); o[3] = (short)f2bf(O[qt][t][3] * rs * sw.w);
          *(bf16x4*)(dst + t * 16 + Q * 4) = o;
        }
      }
    }
  }
}

DI void phase_ssd_scan(const Params& P, int j, char* smem, int cu_idx, int nact) {
  float* sX = (float*)smem;
  float* sB = sX + 32 * 64;
  float* sC = sB + 32 * 128;
  float* sDt = sC + 32 * 128;
  float* sDA = sDt + 32;
  float* sY = sDA + 32;
  bf16* sRaw = (bf16*)(sY + 1024);
  const bf16* XS = (const bf16*)(WSP + OFF_Y);
  const bf16* BCb = (const bf16*)(WSP + OFF_BIG) + (size_t)4 * M * D;
  const float* DT = (const float*)(WSP + OFF_DT);
  bf16* Y0 = (bf16*)(WSP + OFF_H);
  bf16* Y1 = (bf16*)(WSP + OFF_BIG) + (size_t)M * D;
  const int tid = ltid(), prow = tid >> 3, nq = tid & 7;
  if (cu_idx < 0) return;
  for (int item = cu_idx; item < 256; item += nact) {
    const int chain = item >> 1, sp = item & 1;
    const int b = chain >> 5, dir = (chain >> 4) & 1, head = chain & 15, grp = head >> 3;
    const size_t gb = (size_t)b * TB;
    const float a_h = -expf(IN(I_ALOG)[(j * 2 + dir) * 16 + head]);
    const float dbias = IN(I_DTBIAS)[(j * 2 + dir) * 16 + head];
    const float dskip = dir == 0 ? IN(I_SSDD)[j * 16 + head] : 0.f;
    bf16* Yd = dir == 0 ? Y0 : Y1;
    const int myp = sp * 32 + prow;
    const int step = dir == 0 ? 1 : -1;
    float hst[16];
#pragma unroll
    for (int e = 0; e < 16; ++e) hst[e] = 0.f;
    bf16x8 pre[6];
    float predt = 0.f;
    auto issue = [&](int s0n) {
      const bool isctx = s0n < CL;
      const int pfirst = dir == 0 ? s0n : (isctx ? 255 - s0n : 8703 - s0n);
      const int seg_lo = isctx ? 0 : CL, seg_hi = isctx ? CL : TB;
      const int plo = dir == 0 ? pfirst : pfirst - 31;
#pragma unroll
      for (int r = 0; r < 6; ++r) {
        const int id = tid + 256 * r;
        pre[r] = bf16x8{0, 0, 0, 0, 0, 0, 0, 0};
        if (id < 1440) {
          const int rr = id / 40, cc = id - rr * 40;
          const int q = plo - 2 + rr;
          if (q >= seg_lo && q < seg_hi) {
            const bf16* src = cc < 8 ? XS + (gb + q) * 1024 + head * 64 + cc * 8
                                     : (cc < 24 ? BCb + (gb + q) * 512 + grp * 128 + (cc - 8) * 8 : BCb + (gb + q) * 512 + 256 + grp * 128 + (cc - 24) * 8);
            pre[r] = *(const bf16x8*)src;
          }
        }
      }
      if (tid < 32) predt = DT[(gb + pfirst + tid * step) * 32 + dir * 16 + head];
    };
    issue(0);
    for (int s0 = 0; s0 < TB; s0 += 32) {
      const bool isctx = s0 < CL;
      const int pfirst = dir == 0 ? s0 : (isctx ? 255 - s0 : 8703 - s0);
#pragma unroll
      for (int r = 0; r < 6; ++r) {
        const int id = tid + 256 * r;
        if (id < 1440) { const int rr = id / 40, cc = id - rr * 40; *(bf16x8*)(sRaw + rr * 328 + cc * 8) = pre[r]; }
      }
      if (tid < 32) { const float dt = softplusf(predt + dbias); sDt[tid] = dt; sDA[tid] = __expf(dt * a_h); }
      __syncthreads();
      if (s0 + 32 < TB) issue(s0 + 32);
      for (int u = tid; u < 640; u += 256) {
        const int c = u % 320, hf = u / 320;
        int ch; float* dstp; int dld;
        if (c < 64) { ch = head * 64 + c; dstp = sX + c; dld = 64; }
        else if (c < 192) { const int n = c - 64; ch = 1024 + grp * 128 + n; dstp = sB + n; dld = 128; }
        else { const int n = c - 192; ch = 1280 + grp * 128 + n; dstp = sC + n; dld = 128; }
        float raw[20];
#pragma unroll
        for (int i = 0; i < 20; ++i) raw[i] = bf2f(sRaw[(hf * 16 + i) * 328 + c]);
        const float* cw = IN(I_CONVW) + (size_t)j * 5 * 1536 + ch;
        const float w0 = cw[0], w1 = cw[1536], w2 = cw[2 * 1536], w3 = cw[3 * 1536], w4 = cw[4 * 1536];
        const float cbias = IN(I_CONVB)[j * 1536 + ch];
#pragma unroll
        for (int ii = 0; ii < 16; ++ii) {
          float v = cbias + w0 * raw[ii] + w1 * raw[ii + 1] + w2 * raw[ii + 2] + w3 * raw[ii + 3] + w4 * raw[ii + 4];
          v = v * __builtin_amdgcn_rcpf(1.f + __expf(-v));
          const int nl = hf * 16 + ii;
          const int li = dir == 0 ? nl : 31 - nl;
          dstp[li * dld] = v;
        }
      }
      __syncthreads();
      float4 bq[4], cq[4];
#pragma unroll
      for (int e = 0; e < 4; ++e) { bq[e] = *(const float4*)(sB + nq * 16 + e * 4); cq[e] = *(const float4*)(sC + nq * 16 + e * 4); }
      float xv = sX[myp], dt = sDt[0], dA = sDA[0];
#pragma unroll 2
      for (int i = 0; i < 32; ++i) {
        const int in = i < 31 ? i + 1 : 31;
        float4 nb[4], nc[4];
#pragma unroll
        for (int e = 0; e < 4; ++e) { nb[e] = *(const float4*)(sB + in * 128 + nq * 16 + e * 4); nc[e] = *(const float4*)(sC + in * 128 + nq * 16 + e * 4); }
        const float nxv = sX[in * 64 + myp], ndt = sDt[in], ndA = sDA[in];
        const float xdt = xv * dt;
        float pp[4];
#pragma unroll
        for (int e = 0; e < 4; ++e) {
          hst[4 * e + 0] = dA * hst[4 * e + 0] + xdt * bq[e].x; hst[4 * e + 1] = dA * hst[4 * e + 1] + xdt * bq[e].y;
          hst[4 * e + 2] = dA * hst[4 * e + 2] + xdt * bq[e].z; hst[4 * e + 3] = dA * hst[4 * e + 3] + xdt * bq[e].w;
          pp[e] = (cq[e].x * hst[4 * e + 0] + cq[e].y * hst[4 * e + 1]) + (cq[e].z * hst[4 * e + 2] + cq[e].w * hst[4 * e + 3]);
        }
        float part = (pp[0] + pp[1]) + (pp[2] + pp[3]);
        part = red8(part);
        if (nq == 0) sY[i * 32 + prow] = part + dskip * xv;
#pragma unroll
        for (int e = 0; e < 4; ++e) { bq[e] = nb[e]; cq[e] = nc[e]; }
        xv = nxv; dt = ndt; dA = ndA;
      }
      __syncthreads();
      {
        const int i = tid >> 3, r4 = (tid & 7) * 4;
        const int p = pfirst + i * step;
        bf16x4 o;
        o[0] = (short)f2bf(sY[i * 32 + r4]); o[1] = (short)f2bf(sY[i * 32 + r4 + 1]); o[2] = (short)f2bf(sY[i * 32 + r4 + 2]); o[3] = (short)f2bf(sY[i * 32 + r4 + 3]);
        *(bf16x4*)(Yd + (gb + p) * D + head * 64 + sp * 32 + r4) = o;
      }
    }
    __syncthreads();
  }
}

DI void phase_bcconv(const Params& P, int j) {
  const int lane = ltid() & 63;
  const int gw = lbid() * 4 + (ltid() >> 6), nw = gridDim.x * 4;
  const bf16* BCb = (const bf16*)(WSP + OFF_BIG) + (size_t)4 * M * D;
  bf16* BCc = (bf16*)(WSP + OFF_BIG) + (size_t)2 * M * D;
  const float* cw = IN(I_CONVW) + (size_t)j * 5 * 1536 + 1024 + lane * 8;
  const float* cb = IN(I_CONVB) + j * 1536 + 1024 + lane * 8;
  float w[5][8], bias[8];
#pragma unroll
  for (int t = 0; t < 5; ++t)
#pragma unroll
    for (int e = 0; e < 8; ++e) w[t][e] = cw[t * 1536 + e];
#pragma unroll
  for (int e = 0; e < 8; ++e) bias[e] = cb[e];
  for (int run = gw; run < M / 16; run += nw) {
    const int g0 = run * 16, b = g0 / TB, p0 = g0 - b * TB;
    const int seg_lo = p0 < CL ? 0 : CL, seg_hi = p0 < CL ? CL : TB;
    bf16x8 win[5];
#pragma unroll
    for (int t = 0; t < 4; ++t) {
      const int q = p0 - 2 + t;
      win[t + 1] = (q >= seg_lo && q < seg_hi) ? *(const bf16x8*)(BCb + ((size_t)b * TB + q) * 512 + lane * 8) : bf16x8{0, 0, 0, 0, 0, 0, 0, 0};
    }
#pragma unroll 4
    for (int i = 0; i < 16; ++i) {
#pragma unroll
      for (int t = 0; t < 4; ++t) win[t] = win[t + 1];
      const int q = p0 + i + 2;
      win[4] = (q < seg_hi) ? *(const bf16x8*)(BCb + ((size_t)b * TB + q) * 512 + lane * 8) : bf16x8{0, 0, 0, 0, 0, 0, 0, 0};
      bf16x8 o;
#pragma unroll
      for (int e = 0; e < 8; ++e) {
        float v = bias[e];
#pragma unroll
        for (int t = 0; t < 5; ++t) v += w[t][e] * bf2f((bf16)win[t][e]);
        v = v * __builtin_amdgcn_rcpf(1.f + __expf(-v));
        o[e] = (short)f2bf(v);
      }
      *(bf16x8*)(BCc + ((size_t)g0 + i) * 512 + lane * 8) = o;
    }
  }
}

DI void phase_ssd_chunk(const Params& P, int j, char* smem, int cu_idx, int nact) {
  bf16* sB = (bf16*)smem;
  bf16* sC = sB + 32 * 136;
  bf16* sBt = sC + 32 * 136;
  bf16* sXd = sBt + 128 * 40;
  bf16* sGm = sXd + 64 * 40;
  bf16* sH = sGm + 32 * 40;
  bf16* sXr = sH + 64 * 136;
  float* sDt = (float*)(sXr + 36 * 72);
  float* sAcs = sDt + 32;
  float* sScl = sAcs + 32;
  const bf16* XS = (const bf16*)(WSP + OFF_Y);
  const bf16* BCc = (const bf16*)(WSP + OFF_BIG) + (size_t)2 * M * D;
  const float* DT = (const float*)(WSP + OFF_DT);
  bf16* Y0 = (bf16*)(WSP + OFF_H);
  bf16* Y1 = (bf16*)(WSP + OFF_BIG) + (size_t)M * D;
  const int tid = ltid(), lane = tid & 63, wave = tid >> 6, l15 = lane & 15, Q = lane >> 4;
  if (cu_idx < 0) return;
  for (int item = cu_idx; item < 128; item += nact) {
    const int b = item >> 5, dir = (item >> 4) & 1, head = item & 15, grp = head >> 3;
    const size_t gb = (size_t)b * TB;
    const float a_h = -expf(IN(I_ALOG)[(j * 2 + dir) * 16 + head]);
    const float dbias = IN(I_DTBIAS)[(j * 2 + dir) * 16 + head];
    const float dskip = dir == 0 ? IN(I_SSDD)[j * 16 + head] : 0.f;
    bf16* Yd = dir == 0 ? Y0 : Y1;
    const int step = dir == 0 ? 1 : -1;
    const int cch = tid & 63, cq = tid >> 6;
    const float* cwp = IN(I_CONVW) + (size_t)j * 5 * 1536 + head * 64 + cch;
    const float w0 = cwp[0], w1 = cwp[1536], w2 = cwp[2 * 1536], w3 = cwp[3 * 1536], w4 = cwp[4 * 1536];
    const float cbias = IN(I_CONVB)[j * 1536 + head * 64 + cch];
    __syncthreads();
    for (int i = tid; i < 64 * 136 / 8; i += 256) *(bf16x8*)(sH + i * 8) = bf16x8{0, 0, 0, 0, 0, 0, 0, 0};
    f32x4 hacc[8];
#pragma unroll
    for (int t = 0; t < 8; ++t) hacc[t] = f32x4{0.f, 0.f, 0.f, 0.f};
    struct PF { bf16x8 px[2], pbc[4]; float predt; };
    PF pfa, pfb;
    pfa.predt = 0.f; pfb.predt = 0.f;
    auto issue = [&](PF& pf, int s0n) {
      const bool isctx = s0n < CL;
      const int pfirst = dir == 0 ? s0n : (isctx ? 255 - s0n : 8703 - s0n);
      const int seg_lo = isctx ? 0 : CL, seg_hi = isctx ? CL : TB;
      const int plo = dir == 0 ? pfirst : pfirst - 31;
#pragma unroll
      for (int r = 0; r < 2; ++r) {
        const int id = tid + 256 * r;
        pf.px[r] = bf16x8{0, 0, 0, 0, 0, 0, 0, 0};
        if (id < 288) {
          const int rr = id >> 3, cc = id & 7, q = plo - 2 + rr;
          if (q >= seg_lo && q < seg_hi) pf.px[r] = *(const bf16x8*)(XS + (gb + q) * 1024 + head * 64 + cc * 8);
        }
      }
#pragma unroll
      for (int r = 0; r < 4; ++r) {
        const int id = tid + 256 * r, li = id >> 5, cc = id & 31;
        const size_t gi = gb + pfirst + li * step;
        pf.pbc[r] = *(const bf16x8*)(BCc + gi * 512 + (cc < 16 ? grp * 128 + cc * 8 : 256 + grp * 128 + (cc - 16) * 8));
      }
      if (tid < 32) pf.predt = DT[(gb + pfirst + tid * step) * 32 + dir * 16 + head];
    };
    issue(pfa, 0);
    issue(pfb, 32);
    auto chunk = [&](int s0, PF& pf) {
      const bool isctx = s0 < CL;
      const int pfirst = dir == 0 ? s0 : (isctx ? 255 - s0 : 8703 - s0);
#pragma unroll
      for (int r = 0; r < 2; ++r) {
        const int id = tid + 256 * r;
        if (id < 288) *(bf16x8*)(sXr + (id >> 3) * 72 + (id & 7) * 8) = pf.px[r];
      }
#pragma unroll
      for (int r = 0; r < 4; ++r) {
        const int id = tid + 256 * r, li = id >> 5, cc = id & 31;
        if (cc < 16) *(bf16x8*)(sB + li * 136 + cc * 8) = pf.pbc[r];
        else *(bf16x8*)(sC + li * 136 + (cc - 16) * 8) = pf.pbc[r];
      }
      if (wave == 0) {
        const float xx = pf.predt + dbias, ex = __expf(xx);
        const float dt = xx > 20.f ? xx : (ex < 0.01f ? ex * (1.f - ex * (0.5f - ex * 0.33333334f)) : __logf(1.f + ex));
        float v = dt * a_h;
        v += __int_as_float(__builtin_amdgcn_update_dpp(0, __float_as_int(v), 0x111, 0xf, 0xf, true));
        v += __int_as_float(__builtin_amdgcn_update_dpp(0, __float_as_int(v), 0x112, 0xf, 0xf, true));
        v += __int_as_float(__builtin_amdgcn_update_dpp(0, __float_as_int(v), 0x114, 0xf, 0xf, true));
        v += __int_as_float(__builtin_amdgcn_update_dpp(0, __float_as_int(v), 0x118, 0xf, 0xf, true));
        const float r0 = __int_as_float(__builtin_amdgcn_readlane(__float_as_int(v), 15));
        if (lane >= 16) v += r0;
        const float lastv = __int_as_float(__builtin_amdgcn_readlane(__float_as_int(v), 31));
        if (lane < 32) { sDt[lane] = dt; sAcs[lane] = v; sScl[lane] = __expf(lastv - v); }
      }
      __syncthreads();
      if (s0 + 64 < TB) issue(pf, s0 + 64);
      const float acs_last = sAcs[31];
      {
        float raw[12];
#pragma unroll
        for (int i = 0; i < 12; ++i) raw[i] = bf2f(sXr[(cq * 8 + i) * 72 + cch]);
#pragma unroll
        for (int ii = 0; ii < 8; ++ii) {
          float v = cbias + w0 * raw[ii] + w1 * raw[ii + 1] + w2 * raw[ii + 2] + w3 * raw[ii + 3] + w4 * raw[ii + 4];
          v = v * __builtin_amdgcn_rcpf(1.f + __expf(-v));
          const int nl = cq * 8 + ii, li = dir == 0 ? nl : 31 - nl;
          sXd[cch * 40 + li] = f2bf(v * sDt[li]);
        }
#pragma unroll
        for (int e = 0; e < 2; ++e) {
          const int idx = tid + 256 * e, li = idx & 31, n8 = idx >> 5;
          const bf16x8 bv = *(const bf16x8*)(sB + li * 136 + n8 * 8);
          const float sc = sScl[li];
#pragma unroll
          for (int k = 0; k < 8; ++k) sBt[(n8 * 8 + k) * 40 + li] = f2bf(bf2f((bf16)bv[k]) * sc);
        }
      }
      {
        const int jt = wave >> 1, it = wave & 1;
        f32x4 acc = f32x4{0.f, 0.f, 0.f, 0.f};
        if (jt <= it) {
#pragma unroll
          for (int ks = 0; ks < 4; ++ks)
            acc = MFMA16(*(const bf16x8*)(sB + (16 * jt + l15) * 136 + 32 * ks + 8 * Q), *(const bf16x8*)(sC + (16 * it + l15) * 136 + 32 * ks + 8 * Q), acc);
        }
        const int i = 16 * it + l15;
        const float ai = sAcs[i];
        bf16x4 o;
#pragma unroll
        for (int r = 0; r < 4; ++r) {
          const int jx = 16 * jt + 4 * Q + r;
          float gv = (jx <= i) ? acc[r] * __expf(ai - sAcs[jx]) : 0.f;
          if (jx == i) gv += dskip / sDt[i];
          o[r] = (short)f2bf(gv);
        }
        *(bf16x4*)(sGm + i * 40 + 16 * jt + 4 * Q) = o;
      }
      __syncthreads();
      {
        const bf16x8 ax = *(const bf16x8*)(sXd + (16 * wave + l15) * 40 + 8 * Q);
#pragma unroll
        for (int it = 0; it < 2; ++it) {
          f32x4 accd = f32x4{0.f, 0.f, 0.f, 0.f}, acco = f32x4{0.f, 0.f, 0.f, 0.f};
          accd = MFMA16(ax, *(const bf16x8*)(sGm + (16 * it + l15) * 40 + 8 * Q), accd);
#pragma unroll
          for (int ks = 0; ks < 4; ++ks)
            acco = MFMA16(*(const bf16x8*)(sH + (16 * wave + l15) * 136 + 32 * ks + 8 * Q), *(const bf16x8*)(sC + (16 * it + l15) * 136 + 32 * ks + 8 * Q), acco);
          const int i = 16 * it + l15;
          const float ev = __expf(sAcs[i]);
          bf16x4 o;
#pragma unroll
          for (int r = 0; r < 4; ++r) o[r] = (short)f2bf(accd[r] + ev * acco[r]);
          *(bf16x4*)(Yd + (gb + pfirst + i * step) * D + head * 64 + 16 * wave + 4 * Q) = o;
        }
        const float dec = __expf(acs_last);
#pragma unroll
        for (int nt = 0; nt < 8; ++nt) {
          hacc[nt] = hacc[nt] * dec;
          hacc[nt] = MFMA16(*(const bf16x8*)(sBt + (16 * nt + l15) * 40 + 8 * Q), ax, hacc[nt]);
        }
      }
      __syncthreads();
#pragma unroll
      for (int nt = 0; nt < 8; ++nt) {
        bf16x4 o;
#pragma unroll
        for (int r = 0; r < 4; ++r) o[r] = (short)f2bf(hacc[nt][r]);
        *(bf16x4*)(sH + (16 * wave + l15) * 136 + 16 * nt + 4 * Q) = o;
      }
    };
    for (int s0 = 0; s0 < TB; s0 += 64) {
      chunk(s0, pfa);
      chunk(s0 + 32, pfb);
    }
    __syncthreads();
  }
}

DI void phase_ssd_out(const Params& P, int j) {
  const int lane = ltid() & 63;
  const int gw = lbid() * 4 + (ltid() >> 6), nw = gridDim.x * 4;
  const bf16* Y0 = (const bf16*)(WSP + OFF_H);
  const bf16* Y1 = (const bf16*)(WSP + OFF_BIG) + (size_t)M * D;
  bf16* Zb = (bf16*)(WSP + OFF_BIG) + (size_t)3 * M * D;
  const float* nwp = IN(I_SSDNORM) + j * 1024;
  for (int g = gw; g < M; g += nw) {
    const size_t base = (size_t)g * D + lane * 16;
    float yv[16]; float ss = 0.f;
#pragma unroll
    for (int hh = 0; hh < 2; ++hh) {
      const bf16x8 a = *(const bf16x8*)(Y0 + base + hh * 8), c = *(const bf16x8*)(Y1 + base + hh * 8), z = *(const bf16x8*)(Zb + base + hh * 8);
#pragma unroll
      for (int e = 0; e < 8; ++e) {
        const float v = (bf2f((bf16)a[e]) + bf2f((bf16)c[e])) * siluf(bf2f((bf16)z[e]));
        yv[hh * 8 + e] = v; ss += v * v;
      }
    }
#pragma unroll
    for (int o = 16; o >= 1; o >>= 1) ss += __shfl_xor(ss, o);
    const float rs = rsqrtf(ss * (1.f / 512.f) + 1e-5f);
#pragma unroll
    for (int hh = 0; hh < 2; ++hh) {
      bf16x8 o;
#pragma unroll
      for (int e = 0; e < 8; ++e) o[e] = (short)f2bf(yv[hh * 8 + e] * rs * nwp[lane * 16 + hh * 8 + e]);
      *(bf16x8*)(Zb + base + hh * 8) = o;
    }
  }
}

DI void phase_wkv_scan(const Params& P, int j, char* smem, int cu_idx, int nact) {
  float* sR = (float*)smem;
  float* sKK = sR + 2048;
  float* sW = sKK + 2048;
  float* sBv = sW + 2048;
  float* sKd = sBv + 2048;
  float* sV = sKd + 2048;
  float* sY = sV + 2048;
  float* sKKW = sY + 1024;
  float* sRKW = sKKW + 64;
  const bf16* R = (const bf16*)(WSP + OFF_BIG);
  const bf16* K = R + (size_t)M * D;
  const bf16* V = K + (size_t)M * D;
  const bf16* TW = (const bf16*)(WSP + OFF_TW);
  const bf16* TA = (const bf16*)(WSP + OFF_TA);
  float* RKo = (float*)(WSP + OFF_RK);
  bf16* Y0 = (bf16*)(WSP + OFF_H);
  bf16* Y1 = (bf16*)(WSP + OFF_Y);
  const int tid = ltid(), lane = tid & 63, wave = tid >> 6, l15 = lane & 15, Q = lane >> 4;
  const int prow = tid >> 3, kq = tid & 7;
  if (cu_idx < 0) return;
  for (int item = cu_idx; item < 256; item += nact) {
    const int chain = item >> 1, sp = item & 1;
    const int b = chain >> 5, dir = (chain >> 4) & 1, head = chain & 15;
    const size_t gb = (size_t)b * TB;
    bf16* Yd = dir == 0 ? Y0 : Y1;
    const int hc0 = head * 64;
    const int step = dir == 0 ? 1 : -1;
    bf16x8 Bw[2], Ba[2];
    {
      const float* w2 = IN(I_W2) + (size_t)(j * 2 + dir) * 64 * 1024 + hc0 + wave * 16 + l15;
      const float* a2 = IN(I_A2) + (size_t)(j * 2 + dir) * 64 * 1024 + hc0 + wave * 16 + l15;
#pragma unroll
      for (int ks = 0; ks < 2; ++ks)
#pragma unroll
        for (int jj = 0; jj < 8; ++jj) Bw[ks][jj] = (short)f2bf(w2[(size_t)(ks * 32 + Q * 8 + jj) * 1024]);
#pragma unroll
      for (int ks = 0; ks < 2; ++ks)
#pragma unroll
        for (int jj = 0; jj < 8; ++jj) Ba[ks][jj] = (short)f2bf(a2[(size_t)(ks * 32 + Q * 8 + jj) * 1024]);
    }
    bf16x8* sFr = (bf16x8*)(smem + 55296);
    sFr[tid] = Bw[0]; sFr[256 + tid] = Bw[1]; sFr[512 + tid] = Ba[0]; sFr[768 + tid] = Ba[1];
    const int ccol = hc0 + wave * 16 + l15;
    const float w0c = IN(I_W0)[(j * 2 + dir) * 1024 + ccol];
    const float a0c = IN(I_A0)[(j * 2 + dir) * 1024 + ccol];
    const float kac = IN(I_KA)[j * 1024 + ccol];
    const int myrow = sp * 32 + prow;
    const int ta_t = tid >> 3, ta_c8 = (tid & 7) * 8;
    __syncthreads();
    if (tid < 64) { sKKW[tid] = IN(I_KK)[j * 1024 + hc0 + tid]; sRKW[tid] = IN(I_RK)[j * 1024 + hc0 + tid]; }
    __syncthreads();
    float S[8] = {0.f, 0.f, 0.f, 0.f, 0.f, 0.f, 0.f, 0.f};
    bf16x8 prv, pkv, pvv, pfw[2][2], pfa[2][2];
    auto issue = [&](int s0n) {
      const bool isctx = s0n < CL;
      const int pfirst = dir == 0 ? s0n : (isctx ? 255 - s0n : 8703 - s0n);
      const size_t gi = gb + pfirst + ta_t * step;
      prv = *(const bf16x8*)(R + gi * D + hc0 + ta_c8);
      pkv = *(const bf16x8*)(K + gi * D + hc0 + ta_c8);
      pvv = *(const bf16x8*)(V + gi * D + hc0 + ta_c8);
#pragma unroll
      for (int mt = 0; mt < 2; ++mt) {
        const size_t g2 = gb + pfirst + (mt * 16 + l15) * step;
#pragma unroll
        for (int ks = 0; ks < 2; ++ks) {
          pfw[mt][ks] = *(const bf16x8*)(TW + g2 * 128 + dir * 64 + ks * 32 + Q * 8);
          pfa[mt][ks] = *(const bf16x8*)(TA + g2 * 128 + dir * 64 + ks * 32 + Q * 8);
        }
      }
    };
    issue(0);
    for (int s0 = 0; s0 < TB; s0 += 32) {
      const bool isctx = s0 < CL;
      const int pfirst = dir == 0 ? s0 : (isctx ? 255 - s0 : 8703 - s0);
      {
        float kk[8]; float ss = 0.f;
#pragma unroll
        for (int e = 0; e < 8; ++e) { kk[e] = bf2f((bf16)pkv[e]) * sKKW[ta_c8 + e]; ss += kk[e] * kk[e]; }
        ss = red8(ss);
        const float inv = fminf(__builtin_amdgcn_rsqf(ss), 1e12f);
#pragma unroll
        for (int e = 0; e < 8; ++e) {
          sR[ta_t * 64 + ta_c8 + e] = bf2f((bf16)prv[e]);
          sKd[ta_t * 64 + ta_c8 + e] = bf2f((bf16)pkv[e]);
          sKK[ta_t * 64 + ta_c8 + e] = kk[e] * inv;
          sV[ta_t * 64 + ta_c8 + e] = bf2f((bf16)pvv[e]);
        }
      }
      f32x4 aw[2], aa[2];
#pragma unroll
      for (int mt = 0; mt < 2; ++mt) {
        aw[mt] = f32x4{0.f, 0.f, 0.f, 0.f}; aa[mt] = f32x4{0.f, 0.f, 0.f, 0.f};
#pragma unroll
        for (int ks = 0; ks < 2; ++ks) {
          aw[mt] = MFMA16(pfw[mt][ks], sFr[ks * 256 + tid], aw[mt]);
          aa[mt] = MFMA16(pfa[mt][ks], sFr[512 + ks * 256 + tid], aa[mt]);
        }
      }
      __syncthreads();
      if (s0 + 32 < TB) issue(s0 + 32);
#pragma unroll
      for (int mt = 0; mt < 2; ++mt)
#pragma unroll
        for (int r = 0; r < 4; ++r) {
          const int t = mt * 16 + Q * 4 + r, idx = t * 64 + wave * 16 + l15;
          const float wl = w0c + aw[mt][r];
          const float ee = 0.6065306597f * __builtin_amdgcn_rcpf(1.f + __expf(-wl));
          const float a = __builtin_amdgcn_rcpf(1.f + __expf(-(a0c + aa[mt][r])));
          const float kraw = sKd[idx], kk = sKK[idx];
          sW[idx] = __expf(-ee);
          sBv[idx] = kk * a;
          sKd[idx] = kraw * (1.f + (a - 1.f) * kac);
          sKK[idx] = -kk;
        }
      __syncthreads();
      if (sp == 0) {
        float s = 0.f;
#pragma unroll
        for (int e = 0; e < 8; ++e) s += sR[ta_t * 64 + ta_c8 + e] * sRKW[ta_c8 + e] * sKd[ta_t * 64 + ta_c8 + e];
        s = red8(s);
        if ((tid & 7) == 0) RKo[(gb + pfirst + ta_t * step) * 32 + dir * 16 + head] = s;
      }
      struct OPS { float4 nk0, nk1, wv0, wv1, bv0, bv1, kd0, kd1, rr0, rr1; float vv; };
      OPS oa, ob;
#define WKV_LOAD(o, ii) do { const int in_ = (ii) < 32 ? (ii) : 31; \
        (o).nk0 = *(const float4*)(sKK + in_ * 64 + kq * 8); (o).nk1 = *(const float4*)(sKK + in_ * 64 + kq * 8 + 4); \
        (o).wv0 = *(const float4*)(sW + in_ * 64 + kq * 8);  (o).wv1 = *(const float4*)(sW + in_ * 64 + kq * 8 + 4); \
        (o).bv0 = *(const float4*)(sBv + in_ * 64 + kq * 8); (o).bv1 = *(const float4*)(sBv + in_ * 64 + kq * 8 + 4); \
        (o).kd0 = *(const float4*)(sKd + in_ * 64 + kq * 8); (o).kd1 = *(const float4*)(sKd + in_ * 64 + kq * 8 + 4); \
        (o).rr0 = *(const float4*)(sR + in_ * 64 + kq * 8);  (o).rr1 = *(const float4*)(sR + in_ * 64 + kq * 8 + 4); \
        (o).vv = sV[in_ * 64 + myrow]; } while (0)
#define WKV_STEP(o, ii) do { \
        float sa = ((S[0] * (o).nk0.x + S[1] * (o).nk0.y) + (S[2] * (o).nk0.z + S[3] * (o).nk0.w)) + ((S[4] * (o).nk1.x + S[5] * (o).nk1.y) + (S[6] * (o).nk1.z + S[7] * (o).nk1.w)); \
        sa = red8(sa); \
        S[0] = S[0] * (o).wv0.x + (sa * (o).bv0.x + (o).vv * (o).kd0.x); S[1] = S[1] * (o).wv0.y + (sa * (o).bv0.y + (o).vv * (o).kd0.y); \
        S[2] = S[2] * (o).wv0.z + (sa * (o).bv0.z + (o).vv * (o).kd0.z); S[3] = S[3] * (o).wv0.w + (sa * (o).bv0.w + (o).vv * (o).kd0.w); \
        S[4] = S[4] * (o).wv1.x + (sa * (o).bv1.x + (o).vv * (o).kd1.x); S[5] = S[5] * (o).wv1.y + (sa * (o).bv1.y + (o).vv * (o).kd1.y); \
        S[6] = S[6] * (o).wv1.z + (sa * (o).bv1.z + (o).vv * (o).kd1.z); S[7] = S[7] * (o).wv1.w + (sa * (o).bv1.w + (o).vv * (o).kd1.w); \
        float y = ((S[0] * (o).rr0.x + S[1] * (o).rr0.y) + (S[2] * (o).rr0.z + S[3] * (o).rr0.w)) + ((S[4] * (o).rr1.x + S[5] * (o).rr1.y) + (S[6] * (o).rr1.z + S[7] * (o).rr1.w)); \
        y = red8(y); \
        if (kq == 0) sY[(ii) * 32 + prow] = y; } while (0)
      WKV_LOAD(oa, 0);
#pragma unroll 2
      for (int i = 0; i < 32; i += 2) {
        WKV_LOAD(ob, i + 1);
        WKV_STEP(oa, i);
        WKV_LOAD(oa, i + 2);
        WKV_STEP(ob, i + 1);
      }
#undef WKV_LOAD
#undef WKV_STEP
      __syncthreads();
      {
        const int i = tid >> 3, r4 = (tid & 7) * 4;
        const int p = pfirst + i * step;
        bf16x4 o;
        o[0] = (short)f2bf(sY[i * 32 + r4]); o[1] = (short)f2bf(sY[i * 32 + r4 + 1]); o[2] = (short)f2bf(sY[i * 32 + r4 + 2]); o[3] = (short)f2bf(sY[i * 32 + r4 + 3]);
        *(bf16x4*)(Yd + (gb + p) * D + hc0 + sp * 32 + r4) = o;
      }
    }
    __syncthreads();
  }
}

DI void phase_wkv_out(const Params& P, int j) {
  const int lane = ltid() & 63;
  const int gw = lbid() * 4 + (ltid() >> 6), nw = gridDim.x * 4;
  const bf16* Y0 = (const bf16*)(WSP + OFF_H);
  const bf16* Y1 = (const bf16*)(WSP + OFF_Y);
  bf16* R = (bf16*)(WSP + OFF_BIG);
  const bf16* V = R + (size_t)2 * M * D;
  const float* RKi = (const float*)(WSP + OFF_RK);
  const float* lnw = IN(I_LNW) + j * 1024;
  const float* lnb = IN(I_LNB) + j * 1024;
  for (int g = gw; g < M; g += nw) {
    const size_t base = (size_t)g * D + lane * 16;
    const int head = lane >> 2;
    float yv[16], vv[16]; float s = 0.f;
#pragma unroll
    for (int hh = 0; hh < 2; ++hh) {
      const bf16x8 a = *(const bf16x8*)(Y0 + base + hh * 8), c = *(const bf16x8*)(Y1 + base + hh * 8), v = *(const bf16x8*)(V + base + hh * 8);
#pragma unroll
      for (int e = 0; e < 8; ++e) { yv[hh * 8 + e] = bf2f((bf16)a[e]) + bf2f((bf16)c[e]); vv[hh * 8 + e] = bf2f((bf16)v[e]); s += yv[hh * 8 + e]; }
    }
    s = red4(s);
    const float mean = s * (1.f / 64.f);
    float q = 0.f;
#pragma unroll
    for (int e = 0; e < 16; ++e) { const float d = yv[e] - mean; q += d * d; }
    q = red4(q);
    const float rs = rsqrtf(q * (1.f / 64.f) + 64e-5f);
    const float rk = RKi[(size_t)g * 32 + head] + RKi[(size_t)g * 32 + 16 + head];
#pragma unroll
    for (int hh = 0; hh < 2; ++hh) {
      bf16x8 o;
#pragma unroll
      for (int e = 0; e < 8; ++e) {
        const int c = lane * 16 + hh * 8 + e;
        o[e] = (short)f2bf((yv[hh * 8 + e] - mean) * rs * lnw[c] + lnb[c] + rk * vv[hh * 8 + e]);
      }
      *(bf16x8*)(R + base + hh * 8) = o;
    }
  }
}

#define XB_TMO      128
#define XB_XCNT(j)  (256  + 64 * (j))
#define XB_XSUB(j)  (1280 + 64 * (j))
#define XB_XGEN(j)  (2304 + 64 * (j))
#define XB_TOP      3328
#define XB_TOPGEN   3392
#define XCD_BAR_WORDS 3456
#define XB_SPIN_CAP (1u << 23)
#define LAS __attribute__((address_space(3)))

__device__ __forceinline__ unsigned xb_ld(unsigned* p)              { return __hip_atomic_load(p, __ATOMIC_RELAXED, __HIP_MEMORY_SCOPE_AGENT); }
__device__ __forceinline__ unsigned xb_add(unsigned* p, unsigned v) { return __hip_atomic_fetch_add(p, v, __ATOMIC_RELAXED, __HIP_MEMORY_SCOPE_AGENT); }
__device__ __forceinline__ unsigned xb_xcc_id() { return (unsigned)__builtin_amdgcn_s_getreg((3 << 11) | 20) & 0xFu; }
#define XB_SPIN(cond, bar) do { unsigned _sp = 0; while (cond) { __builtin_amdgcn_s_sleep(1); \
    if ((++_sp & 255u) == 0u) { if (xb_ld(&(bar)[XB_TMO])) break; if (_sp > XB_SPIN_CAP) { atomicAdd(&(bar)[XB_TMO], 1u); break; } } } } while (0)

struct XcdBarrier {
    unsigned* bar; unsigned x;
    volatile LAS unsigned* st;
};

__device__ __forceinline__ XcdBarrier xcd_barrier_post(unsigned* bar, volatile LAS unsigned* st) {
    XcdBarrier b; b.bar = bar; b.x = xb_xcc_id(); b.st = st;
    if (threadIdx.x == 0) (void)xb_add(&bar[XB_XCNT(b.x)], 1u);
    return b;
}
__device__ __forceinline__ void xcd_barrier_complete(unsigned* bar, unsigned x, unsigned& nloc, unsigned& nx) {
    const unsigned G = gridDim.x * gridDim.y * gridDim.z;
    unsigned sum, cnt, mine, sp = 0u;
    for (;;) {
        sum = 0u; cnt = 0u; mine = 0u;
#pragma unroll
        for (unsigned j = 0; j < 16; ++j) { const unsigned c = xb_ld(&bar[XB_XCNT(j)]); sum += c; cnt += (c > 0u) ? 1u : 0u; mine = (j == x) ? c : mine; }
        if (sum == G) break;
        __builtin_amdgcn_s_sleep(1);
        if ((++sp & 255u) == 0u) { if (xb_ld(&bar[XB_TMO])) break; if (sp > XB_SPIN_CAP) { atomicAdd(&bar[XB_TMO], 1u); break; } }
    }
    nloc = mine > 0u ? mine : 1u; nx = cnt > 0u ? cnt : 1u;
}

__device__ __forceinline__ void xcd_barrier(const XcdBarrier& b) {
    asm volatile("s_waitcnt vmcnt(0)" ::: "memory");
    __syncthreads();
    if (threadIdx.x == 0) {
        unsigned* bar = b.bar;
        __builtin_amdgcn_s_waitcnt(0);
        unsigned nloc = b.st[0], nx = b.st[1];
        if (nloc == 0u) { xcd_barrier_complete(bar, b.x, nloc, nx); b.st[0] = nloc; b.st[1] = nx; }
        const unsigned old = xb_add(&bar[XB_XSUB(b.x)], 1u);
        const unsigned gen = old / nloc;
        if (old + 1u == (gen + 1u) * nloc) {
            __builtin_amdgcn_fence(__ATOMIC_RELEASE, "agent");
            asm volatile("s_waitcnt vmcnt(0)" ::: "memory");
            const unsigned og = xb_add(&bar[XB_TOP], 1u);
            const unsigned tg = og / nx;
            if (og + 1u == (tg + 1u) * nx) xb_add(&bar[XB_TOPGEN], 1u);
            else XB_SPIN(xb_ld(&bar[XB_TOPGEN]) == tg, bar);
            __builtin_amdgcn_fence(__ATOMIC_ACQUIRE, "agent");
            xb_add(&bar[XB_XGEN(b.x)], 1u);
            asm volatile("s_waitcnt vmcnt(0)" ::: "memory");
        } else {
            XB_SPIN(xb_ld(&bar[XB_XGEN(b.x)]) == gen, bar);
            __builtin_amdgcn_fence(__ATOMIC_ACQUIRE, "agent");
            asm volatile("s_waitcnt vmcnt(0)" ::: "memory");
        }
    }
    __syncthreads();
}


enum { OP_NOP = 0, OP_INIT, OP_CONVERT, OP_POSTPRE, OP_FFN_IN, OP_FFN_OUT, OP_EVENIN, OP_ATTN, OP_SSD, OP_SSDOUT, OP_EVENOUT,
       OP_MIX, OP_VMIX, OP_WKV, OP_WKVOUT, OP_GMUL, OP_WO, OP_BCCONV };
enum { KG_NONE = 0, KG_SWIGLU, KG_STORE, KG_EVENIN, KG_MIX, KG_MIXS, KG_VMIX, KG_GMUL };

__global__ void __launch_bounds__(256, 2) mega_kernel(Params P0) {
  cg::grid_group grid = cg::this_grid();
  __shared__ __attribute__((aligned(16))) char smem[73728];
  __shared__ Params sP;
  if (threadIdx.x < 40) sP.in[threadIdx.x] = P0.in[threadIdx.x];
  if (threadIdx.x == 40) sP.xlat = P0.xlat;
  if (threadIdx.x == 41) sP.ws = P0.ws;
  __shared__ uint4 xb_words;
  if (threadIdx.x == 0) xb_words = make_uint4(0u, 0u, 0u, 0u);
  __syncthreads();
  XcdBarrier xb = xcd_barrier_post((unsigned*)(P0.ws + OFF_BAR), (volatile LAS unsigned*)&xb_words);
  __shared__ int s_cu_idx, s_r1_idx;
  if (threadIdx.x == 0) {
    unsigned* tab = (unsigned*)(P0.ws + OFF_CENSUS);
    const unsigned hw = (unsigned)__builtin_amdgcn_s_getreg((15 << 11) | 4);
    const unsigned key = xb_xcc_id() * 256u + ((hw >> 8) & 0xFFu);
    const unsigned r = xb_add(&tab[key], 1u);
    s_cu_idx = (r == 0u) ? (int)xb_add(&tab[2048], 1u) : -1;
    s_r1_idx = (r == 0u) ? -1 : (int)xb_add(&tab[2049], 1u);
  }
  __syncthreads();
  const Params& P = sP;
#pragma unroll 1
  for (int pc = -3; pc < 80; ++pc) {
    bf16* H = (bf16*)(WSP + OFF_H);
    bf16* Y = (bf16*)(WSP + OFF_Y);
    bf16* BIG = (bf16*)(WSP + OFF_BIG);
    const bf16* W = (const bf16*)(WSP + OFF_W) + (size_t)((pc < 0 ? 0 : pc / 20) & 1) * W_STRIDE;
    int op = OP_NOP, arg = 0, sync = 0, l = 0;
    if (pc == -3) { op = OP_INIT; sync = 1; }
    else if (pc == -2) { op = OP_CONVERT; arg = 0; }
    else if (pc == -1) { op = OP_POSTPRE; arg = 3; sync = 1; }
    else {
      l = pc / 20;
      const int s = pc - l * 20;
      const bool odd = (l & 1) != 0;
      const int j = l >> 1;
      if (s == 0) { op = OP_FFN_IN; arg = 0; sync = 1; }
      else if (s == 1) { op = OP_FFN_OUT; arg = 0; sync = 1; }
      else if (s == 2) { op = OP_POSTPRE; arg = 0; sync = 1; }
      else if (s <= 14) {
        if (!odd) {
          if (s == 3) { op = OP_EVENIN; sync = 1; } else if (s == 4) { op = OP_ATTN; sync = 1; } else if (s == 5) { op = OP_BCCONV; sync = 1; }
          else if (s == 6) { op = OP_SSD; sync = 1; } else if (s == 7) { op = OP_SSDOUT; sync = 1; } else if (s == 8) { op = OP_EVENOUT; sync = 1; }
        } else {
          if (s <= 9) { op = OP_MIX; arg = s - 3; sync = (s == 9); if (arg == 6 && j == 0) op = OP_NOP; }
          else if (s == 10) { if (j > 0) { op = OP_VMIX; sync = 1; } }
          else if (s == 11) { op = OP_WKV; sync = 1; } else if (s == 12) { op = OP_WKVOUT; sync = 1; }
          else if (s == 13) { op = OP_GMUL; sync = 1; } else { op = OP_WO; sync = 1; }
        }
      }
      else if (s == 15) { op = OP_POSTPRE; arg = 1; sync = 1; }
      else if (s == 16) { op = OP_FFN_IN; arg = 1; sync = 1; }
      else if (s == 17) { op = OP_FFN_OUT; arg = 1; sync = 1; }
      else if (s == 18) { }
      else { op = OP_POSTPRE; arg = 2; sync = 1; }
    }
    const int j = l >> 1;
#ifndef PROBE_DUP
#define PROBE_DUP 0
#endif
    const int reps = ((PROBE_DUP >> op) & 1) ? 2 : 1;
#pragma unroll 1
    for (int rep = 0; rep < reps; ++rep) {
    GA g = make_ga(H, 1024, W, 1024, 1024, Y, 1024);
    int kind = KG_NONE;
    switch (op) {
      case OP_INIT: phase_init(P, smem); break;
      case OP_CONVERT: phase_convert(P, arg, lbid(), gridDim.x); break;
      case OP_POSTPRE:
        if (arg == 3) phase_postpre(P, false, 0, 0, 0.f, true, 0, 0);
        else if (arg == 0) phase_postpre(P, true, l, 0, 0.5f, true, l, 1);
        else if (arg == 1) phase_postpre(P, true, l, 1, 1.0f, true, l, 2);
        else phase_postpre(P, true, l, 2, 0.5f, l < 3, l + 1, 0);
        break;
      case OP_FFN_IN: g = make_ga(H, 1024, W + (arg ? W_FIN1 : W_FIN0), 1024, 5632, BIG, FH); kind = KG_SWIGLU; break;
      case OP_FFN_OUT: g = make_ga(BIG, FH, W + (arg ? W_FOUT1 : W_FOUT0), FH, 1024, Y, 1024); kind = KG_STORE; break;
      case OP_EVENIN: g = make_ga(H, 1024, W + W_EIN, 1024, 5888, nullptr, 0); kind = KG_EVENIN; break;
      case OP_ATTN: phase_attn(P, j, l, smem, rep + 1 < reps); break;
      case OP_SSD: {
        const int nact = (int)xb_ld((unsigned*)(WSP + OFF_CENSUS) + 2048), nr1 = (int)gridDim.x - nact, nit = nact < 128 ? nact : 128;
        const bool scanner = s_cu_idx >= 0 && s_cu_idx < 128;
        const int ncv = (int)gridDim.x - nit;
        if (scanner) phase_ssd_chunk(P, j, smem, s_cu_idx, nit);
        if (l < 3 && (!scanner || ncv == 0))
          phase_convert(P, l + 1, ncv == 0 ? lbid() : (s_cu_idx < 0 ? s_r1_idx : nr1 + s_cu_idx - 128), ncv == 0 ? (int)gridDim.x : ncv);
      } break;
      case OP_BCCONV: phase_bcconv(P, j); break;
      case OP_SSDOUT: phase_ssd_out(P, j); break;
      case OP_EVENOUT: g = make_ga(BIG, 1024, W + W_EOUT, 2048, 1024, Y, 1024); g.A2 = BIG + (size_t)3 * M * D; g.ksplit = 1024; kind = KG_STORE; break;
      case OP_MIX: {
        const float* mu = IN(I_MU) + (size_t)j * 6 * 1024;
        bf16* R = BIG; bf16* K = BIG + (size_t)M * D; bf16* V = BIG + (size_t)2 * M * D;
        if (arg == 0) { g = make_ga(H, 1024, W + W_R, 1024, 1024, R, 1024); g.mu = mu; }
        else if (arg == 1) { g = make_ga(H, 1024, W + W_K, 1024, 1024, K, 1024); g.mu = mu + 2 * 1024; }
        else if (arg == 2) { g = make_ga(H, 1024, W + W_V, 1024, 1024, V, 1024); g.mu = mu + 3 * 1024; if (j == 0) g.o1 = (bf16*)(WSP + OFF_VF); }
        else if (arg == 3) { g = make_ga(H, 1024, W + W_W1, 1024, 128, (bf16*)(WSP + OFF_TW), 128); g.mu = mu + 1 * 1024; g.act = 1; }
        else if (arg == 4) { g = make_ga(H, 1024, W + W_A1, 1024, 128, (bf16*)(WSP + OFF_TA), 128); g.mu = mu + 4 * 1024; }
        else if (arg == 5) { g = make_ga(H, 1024, W + W_G1, 1024, 160, (bf16*)(WSP + OFF_TG), 160); g.mu = mu + 5 * 1024; g.act = 2; }
        else { g = make_ga(H, 1024, W + W_V1, 1024, 32, (bf16*)(WSP + OFF_TV), 32); g.mu = mu + 3 * 1024; }
        kind = KG_MIXS;
      } break;
      case OP_VMIX: g = make_ga((bf16*)(WSP + OFF_TV), 32, W + W_V2, 32, 1024, BIG + (size_t)2 * M * D, 1024); g.f0 = IN(I_V0) + (size_t)(j - 1) * 1024; kind = KG_VMIX; break;
      case OP_WKV: {
        const int nact = (int)xb_ld((unsigned*)(WSP + OFF_CENSUS) + 2048), nr1 = (int)gridDim.x - nact, nit = nact < 256 ? nact : 256;
        const bool scanner = s_cu_idx >= 0 && s_cu_idx < 256;
        const int ncv = (int)gridDim.x - nit;
        if (scanner) phase_wkv_scan(P, j, smem, s_cu_idx, nit);
        if (l < 3 && (!scanner || ncv == 0))
          phase_convert(P, l + 1, ncv == 0 ? lbid() : (s_cu_idx < 0 ? s_r1_idx : nr1 + s_cu_idx - 256), ncv == 0 ? (int)gridDim.x : ncv);
      } break;
      case OP_WKVOUT: phase_wkv_out(P, j); break;
      case OP_GMUL: g = make_ga((bf16*)(WSP + OFF_TG), 160, W + W_G2, 160, 1024, BIG, 1024); kind = KG_GMUL; break;
      case OP_WO: g = make_ga(BIG, 1024, W + W_O, 1024, 1024, Y, 1024); kind = KG_STORE; break;
      default: break;
    }
    switch (kind) {
      case KG_SWIGLU: gemm_phase<32, 0, EPI_SWIGLU, 8>(P, g, smem); break;
      case KG_STORE: gemm_phase<64, 0, EPI_STORE, 4>(P, g, smem); break;
      case KG_EVENIN: gemm_phase<64, 0, EPI_EVENIN, 4>(P, g, smem); break;

      case KG_MIXS: gemm_phase<64, 1, EPI_STORE, 4>(P, g, smem); break;
      case KG_VMIX: gemm_phase<32, 0, EPI_VMIX, 8>(P, g, smem); break;
      case KG_GMUL: gemm_phase<32, 0, EPI_GMUL, 8>(P, g, smem); break;
      default: break;
    }
    if (sync || rep + 1 < reps) { if (pc == -3) grid.sync(); else xcd_barrier(xb); }
    }
  }
}

extern "C" void kernel_launch(void* const* d_in, const int* in_sizes, int n_in, void* d_out, int out_size, void* d_ws, size_t ws_size,
                              hipStream_t stream) {
  static int grid_blocks = 0;
  if (!grid_blocks) {
    int dev = 0, cus = 0, per_cu = 0;
    hipGetDevice(&dev);
    hipDeviceGetAttribute(&cus, hipDeviceAttributeMultiprocessorCount, dev);
    hipOccupancyMaxActiveBlocksPerMultiprocessor(&per_cu, mega_kernel, 256, 0);
    if (per_cu > 2) per_cu = 2;
    if (per_cu < 1) per_cu = 1;
    grid_blocks = cus * per_cu;
  }
  if (ws_size < WS_NEED) fprintf(stderr, "workspace too small: %zu < %zu\n", ws_size, (size_t)WS_NEED);
  Params p;
  memset(&p, 0, sizeof(p));
  for (int i = 0; i < 40; ++i) p.in[i] = (const float*)d_in[i];
  p.xlat = (float*)d_out;
  p.ws = (char*)d_ws;
  hipMemsetAsync((char*)d_ws + OFF_BAR, 0, 32768, stream);
  void* args[] = {&p};
  hipError_t e = hipLaunchCooperativeKernel((void*)mega_kernel, dim3(grid_blocks), dim3(256), args, 0, stream);
  if (e != hipSuccess) fprintf(stderr, "cooperative launch failed: %s (grid %d)\n", hipGetErrorString(e), grid_blocks);
}
```

```cpp
#include <hip/hip_runtime.h>
#include <hip/hip_cooperative_groups.h>
#include <cstdio>
#include <cstring>
#include <cstdint>
namespace cg = cooperative_groups;

typedef unsigned short bf16;
using bf16x8 = __attribute__((ext_vector_type(8))) short;
using bf16x4 = __attribute__((ext_vector_type(4))) short;
using f32x4 = __attribute__((ext_vector_type(4))) float;
#define DI __device__ __forceinline__

constexpr int D = 1024, NB = 4, CL = 256, TB = 8448, M = 33792, FH = 2816;
constexpr size_t U = (size_t)M * D * 2;

constexpr size_t OFF_H = 0;
constexpr size_t OFF_Y = U;
constexpr size_t OFF_BIG = 2 * U;
constexpr size_t OFF_VF = OFF_BIG + 4 * U + U / 2;
constexpr size_t OFF_W = OFF_VF + U;
constexpr size_t W_STRIDE = 25432064;
constexpr size_t W_ELEMS = 2 * W_STRIDE;
constexpr size_t OFF_TW = OFF_W + W_ELEMS * 2;
constexpr size_t OFF_TA = OFF_TW + (size_t)M * 128 * 2;
constexpr size_t OFF_TG = OFF_TA + (size_t)M * 128 * 2;
constexpr size_t OFF_TV = OFF_TG + (size_t)M * 160 * 2;
constexpr size_t OFF_DT = OFF_TV + (size_t)M * 32 * 2;
constexpr size_t OFF_RK = OFF_DT + (size_t)M * 32 * 4;
constexpr size_t OFF_XCTX = OFF_RK + (size_t)M * 32 * 4;
constexpr size_t OFF_MOD = OFF_XCTX + (size_t)NB * CL * D * 4;
constexpr size_t OFF_ROPE = OFF_MOD + (size_t)4 * 5 * 9216 * 4;
constexpr size_t OFF_BAR = OFF_ROPE + (size_t)128 * 16 * 2 * 4;
constexpr size_t OFF_CENSUS = OFF_BAR + 16384;
constexpr size_t WS_NEED = OFF_CENSUS + 16384;

constexpr size_t W_FIN0 = 0, W_FOUT0 = 5767168, W_FIN1 = 8650752, W_FOUT1 = 14417920, W_MIX = 17301504;
constexpr size_t W_EIN = W_MIX, W_EOUT = W_MIX + 6029312;
constexpr size_t W_R = W_MIX, W_K = W_R + 1048576, W_V = W_K + 1048576, W_O = W_V + 1048576, W_W1 = W_O + 1048576,
                 W_A1 = W_W1 + 131072, W_G1 = W_A1 + 131072, W_V1 = W_G1 + 163840, W_G2 = W_V1 + 32768, W_V2 = W_G2 + 163840;

struct Params {
  const float* in[40];
  float* xlat;
  char* ws;
};

enum { I_X = 0, I_C, I_CTX, I_CCTX, I_ADAW, I_ADAB, I_NORMW, I_FWIN, I_FWOUT, I_EWIN, I_EWOUT, I_LAMBDA, I_SUBLN, I_CONVW, I_CONVB,
       I_DTBIAS, I_ALOG, I_SSDD, I_SSDNORM, I_MU, I_WR, I_WK, I_WV, I_WO, I_W0, I_W1, I_W2, I_A0, I_A1, I_A2, I_G1, I_G2,
       I_KK, I_KA, I_RK, I_LNW, I_LNB, I_V0, I_V1, I_V2 };

DI const void* rfl_ptr(const void* p) {
  unsigned lo = (unsigned)(size_t)p, hi = (unsigned)((size_t)p >> 32);
  lo = __builtin_amdgcn_readfirstlane(lo); hi = __builtin_amdgcn_readfirstlane(hi);
  return (const void*)(__attribute__((address_space(1))) const char*)(((size_t)hi << 32) | (size_t)lo);
}
#define IN(i) ((const float*)rfl_ptr((const void*)P.in[i]))
#define WSP ((char*)rfl_ptr((const void*)P.ws))
#define XLATP ((float*)rfl_ptr((const void*)P.xlat))
DI int ltid() { int t = threadIdx.x; asm volatile("" : "+v"(t)); return t; }
DI int lbid() { int t = blockIdx.x; asm volatile("" : "+s"(t)); return t; }
DI bf16 f2bf(float x) { __bf16 r = (__bf16)x; return __builtin_bit_cast(unsigned short, r); }
DI float bf2f(bf16 v) { return __uint_as_float(((unsigned)v) << 16); }
DI float siluf(float x) { return x / (1.f + __expf(-x)); }
DI float sigmoidf(float x) { return 1.f / (1.f + __expf(-x)); }
DI float softplusf(float x) { return x > 20.f ? x : log1pf(expf(x)); }
template <int CTRL> DI float dppf(float v) { return __int_as_float(__builtin_amdgcn_update_dpp(0, __float_as_int(v), CTRL, 0xf, 0xf, false)); }
DI float red4(float v) { v += dppf<0xB1>(v); v += dppf<0x4E>(v); return v; }
DI float red8(float v) { v = red4(v); v += dppf<0x141>(v); return v; }
DI float red16(float v) { v = red8(v); v += dppf<0x128>(v); return v; }
DI float wave_sum(float v) {
#pragma unroll
  for (int o = 32; o >= 1; o >>= 1) v += __shfl_xor(v, o);
  return v;
}
DI float* xrow(const Params& P, int g) {
  int b = g / TB, p = g - b * TB;
  return p < CL ? (float*)(WSP + OFF_XCTX) + ((size_t)(b * CL + p)) * D : XLATP + ((size_t)b * 8192 + (p - CL)) * D;
}
#define MFMA16(a, b, c) __builtin_amdgcn_mfma_f32_16x16x32_bf16((a), (b), (c), 0, 0, 0)

DI void phase_init(const Params& P, char* smem) {
  const int tid = ltid(), lane = tid & 63, wave = tid >> 6;
  float* sil = (float*)smem;
  float* red = sil + 5 * 1024;
  const float* c = IN(I_C);
  const float* cc = IN(I_CCTX);
  for (int i = tid; i < 5 * 1024; i += 256) {
    int r = i >> 10, k = i & 1023;
    float x = r < 4 ? c[r * 1024 + k] : cc[k];
    sil[i] = x / (1.f + expf(-x));
  }
  __syncthreads();
  float* mod = (float*)(WSP + OFF_MOD);
  for (int item = lbid(); item < 576; item += gridDim.x) {
    int l = item / 144, n = (item % 144) * 64 + lane;
    const float* w = IN(I_ADAW) + (size_t)l * 1024 * 9216 + n;
    float a0 = 0.f, a1 = 0.f, a2 = 0.f, a3 = 0.f, a4 = 0.f;
#pragma unroll 8
    for (int k = wave * 256; k < wave * 256 + 256; ++k) {
      float wv = w[(size_t)k * 9216];
      a0 += sil[k] * wv; a1 += sil[1024 + k] * wv; a2 += sil[2048 + k] * wv; a3 += sil[3072 + k] * wv; a4 += sil[4096 + k] * wv;
    }
    red[(wave * 5 + 0) * 64 + lane] = a0; red[(wave * 5 + 1) * 64 + lane] = a1; red[(wave * 5 + 2) * 64 + lane] = a2;
    red[(wave * 5 + 3) * 64 + lane] = a3; red[(wave * 5 + 4) * 64 + lane] = a4;
    __syncthreads();
    if (wave == 0) {
      float bias = IN(I_ADAB)[l * 9216 + n];
#pragma unroll
      for (int r = 0; r < 5; ++r) {
        float s = red[r * 64 + lane] + red[(5 + r) * 64 + lane] + red[(10 + r) * 64 + lane] + red[(15 + r) * 64 + lane] + bias;
        mod[((size_t)(l * 5 + r)) * 9216 + n] = s;
      }
    }
    __syncthreads();
  }
  if (lbid() == 0) {
    float* cosT = (float*)(WSP + OFF_ROPE);
    float* sinT = cosT + 2048;
    for (int i = tid; i < 2048; i += 256) {
      int pos = i >> 4, f = i & 15;
      float inv = powf(10000.f, -(float)f / 16.f);
      float ang = (float)pos * inv;
      cosT[i] = cosf(ang); sinT[i] = sinf(ang);
    }
  }
  const size_t gt = (size_t)lbid() * 256 + tid, gn = (size_t)gridDim.x * 256;
  const float4* xs = (const float4*)IN(I_X);
  float4* xd = (float4*)XLATP;
  for (size_t i = gt; i < (size_t)NB * 8192 * D / 4; i += gn) xd[i] = xs[i];
  const float4* cs = (const float4*)IN(I_CTX);
  float4* cd = (float4*)(WSP + OFF_XCTX);
  for (size_t i = gt; i < (size_t)NB * CL * D / 4; i += gn) cd[i] = cs[i];
}

DI void conv_job(const float* src, int ld, int K, int Nsrc, int Ndst, bf16* dst, int mapmode, int cbid, int cnb) {
  const size_t gt = (size_t)cbid * 256 + ltid(), gn = (size_t)cnb * 256;
  const size_t total = (size_t)Ndst * (K / 8);
  for (size_t id = gt; id < total; id += gn) {
    int n = (int)(id % Ndst), kc = (int)(id / Ndst);
    int col = n;
    if (mapmode == 1) { int j = 16 * (n >> 5) + (n & 15); col = ((n >> 4) & 1) ? FH + j : j; }
    bf16x8 o;
    if (n < Nsrc) {
      const float* s = src + (size_t)(kc * 8) * ld + col;
#pragma unroll
      for (int jj = 0; jj < 8; ++jj) o[jj] = (short)f2bf(s[(size_t)jj * ld]);
    } else {
#pragma unroll
      for (int jj = 0; jj < 8; ++jj) o[jj] = 0;
    }
    *(bf16x8*)(dst + (size_t)n * K + kc * 8) = o;
  }
}

DI void phase_convert(const Params& P, int l, int cbid, int cnb) {
  bf16* W = (bf16*)(WSP + OFF_W) + (size_t)(l & 1) * W_STRIDE;
  conv_job(IN(I_FWIN) + (size_t)(l * 2 + 0) * 1024 * 5632, 5632, 1024, 5632, 5632, W + W_FIN0, 1, cbid, cnb);
  conv_job(IN(I_FWOUT) + (size_t)(l * 2 + 0) * FH * 1024, 1024, FH, 1024, 1024, W + W_FOUT0, 0, cbid, cnb);
  conv_job(IN(I_FWIN) + (size_t)(l * 2 + 1) * 1024 * 5632, 5632, 1024, 5632, 5632, W + W_FIN1, 1, cbid, cnb);
  conv_job(IN(I_FWOUT) + (size_t)(l * 2 + 1) * FH * 1024, 1024, FH, 1024, 1024, W + W_FOUT1, 0, cbid, cnb);
  const int j = l >> 1;
  if ((l & 1) == 0) {
    conv_job(IN(I_EWIN) + (size_t)j * 1024 * 5664, 5664, 1024, 5664, 5888, W + W_EIN, 0, cbid, cnb);
    conv_job(IN(I_EWOUT) + (size_t)j * 2048 * 1024, 1024, 2048, 1024, 1024, W + W_EOUT, 0, cbid, cnb);
  } else {
    conv_job(IN(I_WR) + (size_t)j * 1048576, 1024, 1024, 1024, 1024, W + W_R, 0, cbid, cnb);
    conv_job(IN(I_WK) + (size_t)j * 1048576, 1024, 1024, 1024, 1024, W + W_K, 0, cbid, cnb);
    conv_job(IN(I_WV) + (size_t)j * 1048576, 1024, 1024, 1024, 1024, W + W_V, 0, cbid, cnb);
    conv_job(IN(I_WO) + (size_t)j * 1048576, 1024, 1024, 1024, 1024, W + W_O, 0, cbid, cnb);
    for (int e = 0; e < 2; ++e) {
      conv_job(IN(I_W1) + (size_t)(j * 2 + e) * 65536, 64, 1024, 64, 64, W + W_W1 + e * 65536, 0, cbid, cnb);
      conv_job(IN(I_A1) + (size_t)(j * 2 + e) * 65536, 64, 1024, 64, 64, W + W_A1 + e * 65536, 0, cbid, cnb);
    }
    conv_job(IN(I_G1) + (size_t)j * 163840, 160, 1024, 160, 160, W + W_G1, 0, cbid, cnb);
    conv_job(IN(I_G2) + (size_t)j * 163840, 1024, 160, 1024, 1024, W + W_G2, 0, cbid, cnb);
    if (j > 0) {
      conv_job(IN(I_V1) + (size_t)(j - 1) * 32768, 32, 1024, 32, 32, W + W_V1, 0, cbid, cnb);
      conv_job(IN(I_V2) + (size_t)(j - 1) * 32768, 1024, 32, 1024, 1024, W + W_V2, 0, cbid, cnb);
    }
  }
}

DI void phase_postpre(const Params& P, bool do_post, int lpost, int spost, float wgt, bool do_pre, int lpre, int spre) {
  const int lane = ltid() & 63;
  const int gw = lbid() * 4 + (ltid() >> 6), nw = gridDim.x * 4;
  const float* mod = (const float*)(WSP + OFF_MOD);
  const bf16* Y = (const bf16*)(WSP + OFF_Y);
  bf16* H = (bf16*)(WSP + OFF_H);
  for (int g = gw; g < M; g += nw) {
    const int b = g / TB, p = g - b * TB, r5 = p < CL ? 4 : b;
    float* x = xrow(P, g);
    float4 xq[4], gq[4], nq[4], shq[4], scq[4], npq[4];
    bf16x4 yq[4];
#pragma unroll
    for (int i = 0; i < 4; ++i) xq[i] = *(const float4*)(x + i * 256 + lane * 4);
    if (do_post) {
      const float* gate = mod + ((size_t)(lpost * 5 + r5) * 9 + 3 * spost + 2) * 1024;
      const float* nwp = IN(I_NORMW) + (size_t)(lpost * 6 + 2 * spost + 1) * 1024;
#pragma unroll
      for (int i = 0; i < 4; ++i) {
        yq[i] = *(const bf16x4*)(Y + (size_t)g * D + i * 256 + lane * 4);
        gq[i] = *(const float4*)(gate + i * 256 + lane * 4);
        nq[i] = *(const float4*)(nwp + i * 256 + lane * 4);
      }
    }
    if (do_pre) {
      const float* shift = mod + ((size_t)(lpre * 5 + r5) * 9 + 3 * spre) * 1024;
      const float* nwp = IN(I_NORMW) + (size_t)(lpre * 6 + 2 * spre) * 1024;
#pragma unroll
      for (int i = 0; i < 4; ++i) {
        shq[i] = *(const float4*)(shift + i * 256 + lane * 4);
        scq[i] = *(const float4*)(shift + 1024 + i * 256 + lane * 4);
        npq[i] = *(const float4*)(nwp + i * 256 + lane * 4);
      }
    }
    float xv[16];
#pragma unroll
    for (int i = 0; i < 4; ++i) { xv[4 * i] = xq[i].x; xv[4 * i + 1] = xq[i].y; xv[4 * i + 2] = xq[i].z; xv[4 * i + 3] = xq[i].w; }
    if (do_post) {
      float yv[16]; float ss = 0.f;
#pragma unroll
      for (int i = 0; i < 4; ++i)
#pragma unroll
        for (int e = 0; e < 4; ++e) { const float v = bf2f((bf16)yq[i][e]); yv[4 * i + e] = v; ss += v * v; }
      ss = wave_sum(ss);
      const float rs = rsqrtf(ss * (1.f / 1024.f) + 1e-6f);
#pragma unroll
      for (int i = 0; i < 4; ++i) {
        xv[4 * i] += wgt * gq[i].x * (yv[4 * i] * rs * nq[i].x);
        xv[4 * i + 1] += wgt * gq[i].y * (yv[4 * i + 1] * rs * nq[i].y);
        xv[4 * i + 2] += wgt * gq[i].z * (yv[4 * i + 2] * rs * nq[i].z);
        xv[4 * i + 3] += wgt * gq[i].w * (yv[4 * i + 3] * rs * nq[i].w);
      }
#pragma unroll
      for (int i = 0; i < 4; ++i) *(float4*)(x + i * 256 + lane * 4) = make_float4(xv[4 * i], xv[4 * i + 1], xv[4 * i + 2], xv[4 * i + 3]);
    }
    if (do_pre) {
      float ss = 0.f;
#pragma unroll
      for (int i = 0; i < 16; ++i) ss += xv[i] * xv[i];
      ss = wave_sum(ss);
      const float rs = rsqrtf(ss * (1.f / 1024.f) + 1e-6f);
#pragma unroll
      for (int i = 0; i < 4; ++i) {
        bf16x4 o;
        o[0] = (short)f2bf(xv[4 * i] * rs * npq[i].x * (1.f + scq[i].x) + shq[i].x);
        o[1] = (short)f2bf(xv[4 * i + 1] * rs * npq[i].y * (1.f + scq[i].y) + shq[i].y);
        o[2] = (short)f2bf(xv[4 * i + 2] * rs * npq[i].z * (1.f + scq[i].z) + shq[i].z);
        o[3] = (short)f2bf(xv[4 * i + 3] * rs * npq[i].w * (1.f + scq[i].w) + shq[i].w);
        *(bf16x4*)(H + (size_t)g * D + i * 256 + lane * 4) = o;
      }
    }
  }
}

struct GA {
  const bf16* A; const bf16* A2; int lda; int ksplit;
  const float* mu;
  const bf16* Wt; int K; int N;
  bf16* o0; bf16* o1; int ldc; int act;
  const float* f0;
};
enum { EPI_STORE = 0, EPI_SWIGLU = 1, EPI_EVENIN = 2, EPI_VMIX = 3, EPI_GMUL = 4 };

template <int EPI, int WN>
DI void gemm_epilogue(const Params& P, const GA& g, int m0, int n0, int wm, int wn, int l15, int Q, f32x4 (&acc)[4][WN]) {
  const int wc0 = n0 + wn * (16 * WN);
  if constexpr (EPI == EPI_STORE) {
#pragma unroll
    for (int mt = 0; mt < 4; ++mt) {
      const size_t row = m0 + wm * 64 + mt * 16 + l15;
#pragma unroll
      for (int nt = 0; nt < WN; ++nt) {
        const int col = wc0 + nt * 16 + 4 * Q;
        if (col < g.N) {
          bf16x4 o;
#pragma unroll
          for (int r = 0; r < 4; ++r) {
            float v = acc[mt][nt][r];
            if (g.act == 1) v = tanhf(v); else if (g.act == 2) v = sigmoidf(v);
            o[r] = (short)f2bf(v);
          }
          *(bf16x4*)(g.o0 + row * g.ldc + col) = o;
          if (g.o1) *(bf16x4*)(g.o1 + row * g.ldc + col) = o;
        }
      }
    }
  } else if constexpr (EPI == EPI_SWIGLU) {
#pragma unroll
    for (int mt = 0; mt < 4; ++mt) {
      const size_t row = m0 + wm * 64 + mt * 16 + l15;
#pragma unroll
      for (int pr = 0; pr < WN / 2; ++pr) {
        const int jcol = (wc0 >> 1) + pr * 16 + 4 * Q;
        bf16x4 o;
#pragma unroll
        for (int r = 0; r < 4; ++r) {
          const float gt = acc[mt][2 * pr][r];
          o[r] = (short)f2bf(gt * __builtin_amdgcn_rcpf(1.f + __expf(-gt)) * acc[mt][2 * pr + 1][r]);
        }
        *(bf16x4*)(g.o0 + row * FH + jcol) = o;
      }
    }
  } else if constexpr (EPI == EPI_EVENIN) {
    bf16* Qb = (bf16*)(WSP + OFF_BIG);
    bf16* Kb = Qb + (size_t)M * D;
    bf16* Vt = Kb + (size_t)M * D;
    bf16* Zb = Vt + (size_t)M * D;
    bf16* BCb = Zb + (size_t)M * D;
    bf16* XS = (bf16*)(WSP + OFF_Y);
    float* DT = (float*)(WSP + OFF_DT);
    if (n0 < 2048) {
      const bool isq = n0 < 1024;
      bf16* dst = isq ? Qb : Kb;
      const float sc = isq ? 0.125f * 1.4426950408889634f : 1.f;
      const float* cosT = (const float*)(WSP + OFF_ROPE);
      const float* sinT = cosT + 2048;
#pragma unroll
      for (int vs = 0; vs < WN / 4; ++vs) {
        const int cb = (isq ? wc0 : wc0 - 1024) + vs * 64 + l15;
#pragma unroll
        for (int mt = 0; mt < 4; ++mt)
#pragma unroll
          for (int r = 0; r < 4; ++r) {
            const int row = m0 + wm * 64 + mt * 16 + 4 * Q + r;
            const int p = row % TB;
            float x1 = acc[mt][4 * vs + 0][r], x2 = acc[mt][4 * vs + 1][r], x3 = acc[mt][4 * vs + 2][r], x4 = acc[mt][4 * vs + 3][r];
            if (p >= CL) {
              const int t = p - CL, pr = t >> 6, pc = t & 63;
              const float cr = cosT[pr * 16 + l15], sr = sinT[pr * 16 + l15], c2 = cosT[pc * 16 + l15], s2 = sinT[pc * 16 + l15];
              const float o1 = x1 * cr - x2 * sr, o2 = x2 * cr + x1 * sr, o3 = x3 * c2 - x4 * s2, o4 = x4 * c2 + x3 * s2;
              x1 = o1; x2 = o2; x3 = o3; x4 = o4;
            }
            bf16* d = dst + (size_t)row * D + cb;
            d[0] = f2bf(x1 * sc); d[16] = f2bf(x2 * sc); d[32] = f2bf(x3 * sc); d[48] = f2bf(x4 * sc);
          }
      }
    } else if (n0 < 3072) {
      const int b = m0 / TB, pb = m0 - b * TB;
#pragma unroll
      for (int mt = 0; mt < 4; ++mt)
#pragma unroll
        for (int nt = 0; nt < WN; ++nt) {
          const int c = wc0 - 2048 + nt * 16 + l15;
          const int p0 = pb + wm * 64 + mt * 16 + 4 * Q;
          bf16x4 o;
#pragma unroll
          for (int r = 0; r < 4; ++r) o[r] = (short)f2bf(acc[mt][nt][r]);
          *(bf16x4*)(Vt + ((size_t)(b * 1024 + c)) * TB + p0) = o;
        }
    } else if (n0 < 5632) {
      bf16* dst; int ld, cb;
      if (n0 < 4096) { dst = Zb; ld = 1024; cb = wc0 - 3072; }
      else if (n0 < 5120) { dst = XS; ld = 1024; cb = wc0 - 4096; }
      else { dst = BCb; ld = 512; cb = wc0 - 5120; }
#pragma unroll
      for (int mt = 0; mt < 4; ++mt)
#pragma unroll
        for (int nt = 0; nt < WN; ++nt)
#pragma unroll
          for (int r = 0; r < 4; ++r) {
            const size_t row = m0 + wm * 64 + mt * 16 + 4 * Q + r;
            dst[row * ld + cb + nt * 16 + l15] = f2bf(acc[mt][nt][r]);
          }
    } else {
#pragma unroll
      for (int mt = 0; mt < 4; ++mt)
#pragma unroll
        for (int nt = 0; nt < WN; ++nt) {
          const int col = wc0 - 5632 + nt * 16 + l15;
          if (col < 32) {
#pragma unroll
            for (int r = 0; r < 4; ++r) {
              const size_t row = m0 + wm * 64 + mt * 16 + 4 * Q + r;
              DT[row * 32 + col] = acc[mt][nt][r];
            }
          }
        }
    }
  } else if constexpr (EPI == EPI_VMIX) {
    const bf16* VF = (const bf16*)(WSP + OFF_VF);
#pragma unroll
    for (int mt = 0; mt < 4; ++mt) {
      const size_t rb = (size_t)(m0 + wm * 64 + mt * 16 + l15) * D + wc0 + 4 * Q;
      bf16x4 ov[WN], of[WN];
      float4 v0[WN];
#pragma unroll
      for (int nt = 0; nt < WN; ++nt) {
        ov[nt] = *(const bf16x4*)(g.o0 + rb + nt * 16);
        of[nt] = *(const bf16x4*)(VF + rb + nt * 16);
        v0[nt] = *(const float4*)(g.f0 + wc0 + nt * 16 + 4 * Q);
      }
#pragma unroll
      for (int nt = 0; nt < WN; ++nt) {
        const float vz[4] = {v0[nt].x, v0[nt].y, v0[nt].z, v0[nt].w};
        bf16x4 o;
#pragma unroll
        for (int r = 0; r < 4; ++r) {
          const float v = bf2f((bf16)ov[nt][r]), vf = bf2f((bf16)of[nt][r]);
          o[r] = (short)f2bf(v + (vf - v) * sigmoidf(vz[r] + acc[mt][nt][r]));
        }
        *(bf16x4*)(g.o0 + rb + nt * 16) = o;
      }
    }
  } else if constexpr (EPI == EPI_GMUL) {
#pragma unroll
    for (int mt = 0; mt < 4; ++mt) {
      const size_t rb = (size_t)(m0 + wm * 64 + mt * 16 + l15) * D + wc0 + 4 * Q;
      bf16x4 ov[WN];
#pragma unroll
      for (int nt = 0; nt < WN; ++nt) ov[nt] = *(const bf16x4*)(g.o0 + rb + nt * 16);
#pragma unroll
      for (int nt = 0; nt < WN; ++nt) {
        bf16x4 o;
#pragma unroll
        for (int r = 0; r < 4; ++r) o[r] = (short)f2bf(bf2f((bf16)ov[nt][r]) * acc[mt][nt][r]);
        *(bf16x4*)(g.o0 + rb + nt * 16) = o;
      }
    }
  }
}

template <int BK, int AMODE, int EPI, int WN>
DI void gemm_phase(const Params& P, const GA& g, char* smem) {
  constexpr int LS = BK;
  constexpr int CPR = BK / 8;
  constexpr int BN = 32 * WN;
  constexpr int NCHA = 128 * CPR / 256, NCHB = BN * CPR / 256;
  constexpr int RSTEP = 256 / CPR;
  constexpr int BUF = (128 + BN) * LS;
  constexpr int GW = 8;
#define SWZ(row, c) ((BK == 64) ? ((c) ^ (((row) >> 1) & 7)) : ((c) ^ ((4 - (((row) >> 2) & 3)) & 3)))
  bf16* S0 = (bf16*)smem;
  const int tid = ltid(), lane = tid & 63, wave = tid >> 6, wm = wave >> 1, wn = wave & 1, l15 = lane & 15, Q = lane >> 4;
  const int ntn = (g.N + BN - 1) / BN, ntiles = (M / 128) * ntn;
  const int nk = g.K / BK;
  const int crow = tid / CPR, ckc = tid - crow * CPR;
  for (int tile = lbid(); tile < ntiles; tile += gridDim.x) {
    int tmi, tni;
    {
      const int x = tile & 7, i = tile >> 3, nfull = ntn / GW, rem = ntn - nfull * GW;
      if (i < nfull * (33 * GW)) { const int g8 = i / (33 * GW), ii = i - g8 * (33 * GW); tni = g8 * GW + (ii % GW); tmi = x * 33 + ii / GW; }
      else { const int ii = i - nfull * (33 * GW); tni = nfull * GW + ii % rem; tmi = x * 33 + ii / rem; }
    }
    const int m0 = tmi * 128, n0 = tni * BN;
    f32x4 acc[4][WN];
#pragma unroll
    for (int i = 0; i < 4; ++i)
#pragma unroll
      for (int j = 0; j < WN; ++j) acc[i][j] = f32x4{0.f, 0.f, 0.f, 0.f};
    struct RS { bf16x8 ra[NCHA], rb[NCHB], rp[AMODE ? NCHA : 1], rn[AMODE ? NCHA : 1]; float muv[AMODE ? 8 : 1]; };
    RS s0, s1;
    auto load_tiles = [&](RS& s, int kt) {
      const int k = kt * BK + ckc * 8;
#pragma unroll
      for (int i = 0; i < NCHA; ++i) {
        const int row = crow + i * RSTEP;
        const size_t gi = (size_t)(m0 + row);
        if constexpr (AMODE == 0) {
          const bf16* src = (g.A2 != nullptr && k >= g.ksplit) ? g.A2 + gi * g.lda + (k - g.ksplit) : g.A + gi * g.lda + k;
          s.ra[i] = *(const bf16x8*)src;
        } else {
          const int p = (int)(gi % TB);
          const bool hp = (p != 0) && (p != CL), hn = (p != CL - 1) && (p != TB - 1);
          const bf16* src = g.A + gi * g.lda + k;
          s.ra[i] = *(const bf16x8*)src;
          s.rp[i] = hp ? *(const bf16x8*)(src - g.lda) : bf16x8{0, 0, 0, 0, 0, 0, 0, 0};
          s.rn[i] = hn ? *(const bf16x8*)(src + g.lda) : bf16x8{0, 0, 0, 0, 0, 0, 0, 0};
        }
      }
#pragma unroll
      for (int i = 0; i < NCHB; ++i) {
        const int n = n0 + crow + i * RSTEP;
        if (n < g.N) s.rb[i] = *(const bf16x8*)(g.Wt + (size_t)n * g.K + k);
        else s.rb[i] = bf16x8{0, 0, 0, 0, 0, 0, 0, 0};
      }
      if constexpr (AMODE == 1) {
        const float4 m0v = *(const float4*)(g.mu + k), m1v = *(const float4*)(g.mu + k + 4);
        s.muv[0] = m0v.x; s.muv[1] = m0v.y; s.muv[2] = m0v.z; s.muv[3] = m0v.w; s.muv[4] = m1v.x; s.muv[5] = m1v.y; s.muv[6] = m1v.z; s.muv[7] = m1v.w;
      }
    };
    auto store_tiles = [&](const RS& s, int buf) {
      bf16* As = S0 + buf * BUF;
      bf16* Bs = As + 128 * LS;
#pragma unroll
      for (int i = 0; i < NCHA; ++i) {
        const int row = crow + i * RSTEP;
        if constexpr (AMODE == 0) {
          *(bf16x8*)(As + row * LS + SWZ(row, ckc) * 8) = s.ra[i];
        } else {
          bf16x8 o;
#pragma unroll
          for (int e = 0; e < 8; ++e) {
            const float hv = bf2f((bf16)s.ra[i][e]);
            const float pv = bf2f((bf16)s.rp[i][e]), nv = bf2f((bf16)s.rn[i][e]);
            o[e] = (short)f2bf(hv + (0.5f * (pv + nv) - hv) * s.muv[e]);
          }
          *(bf16x8*)(As + row * LS + SWZ(row, ckc) * 8) = o;
        }
      }
#pragma unroll
      for (int i = 0; i < NCHB; ++i) *(bf16x8*)(Bs + (crow + i * RSTEP) * LS + SWZ(crow + i * RSTEP, ckc) * 8) = s.rb[i];
    };
    auto compute = [&](int buf) {
      __builtin_amdgcn_s_setprio(1);
      const bf16* As = S0 + buf * BUF;
      const bf16* Bs = As + 128 * LS;
#pragma unroll
      for (int ks = 0; ks < BK / 32; ++ks) {
        bf16x8 af[4], bfr[WN];
#pragma unroll
        for (int t = 0; t < 4; ++t) af[t] = *(const bf16x8*)(As + (wm * 64 + t * 16 + l15) * LS + SWZ(l15, ks * 4 + Q) * 8);
#pragma unroll
        for (int t = 0; t < WN; ++t) bfr[t] = *(const bf16x8*)(Bs + (wn * (16 * WN) + t * 16 + l15) * LS + SWZ(l15, ks * 4 + Q) * 8);
#pragma unroll
        for (int mt = 0; mt < 4; ++mt)
#pragma unroll
          for (int nt = 0; nt < WN; ++nt) {
            if constexpr (EPI != EPI_EVENIN) acc[mt][nt] = MFMA16(bfr[nt], af[mt], acc[mt][nt]);
            else acc[mt][nt] = MFMA16(af[mt], bfr[nt], acc[mt][nt]);
          }
      }
      __builtin_amdgcn_s_setprio(0);
    };
    __syncthreads();
    load_tiles(s0, 0);
    store_tiles(s0, 0);
    if constexpr (AMODE == 0 && WN == 4) {
      if (nk > 1) load_tiles(s0, 1);
      __syncthreads();
      for (int kt = 0; kt < nk; kt += 2) {
        if (kt + 2 < nk) load_tiles(s1, kt + 2);
        compute(0);
        if (kt + 1 < nk) store_tiles(s0, 1);
        __syncthreads();
        if (kt + 1 < nk) {
          if (kt + 3 < nk) load_tiles(s0, kt + 3);
          compute(1);
          if (kt + 2 < nk) store_tiles(s1, 0);
          __syncthreads();
        }
      }
    } else {
      __syncthreads();
      for (int kt = 0; kt < nk; ++kt) {
        if (kt + 1 < nk) load_tiles(s0, kt + 1);
        compute(kt & 1);
        if (kt + 1 < nk) store_tiles(s0, (kt + 1) & 1);
        __syncthreads();
      }
    }
    gemm_epilogue<EPI, WN>(P, g, m0, n0, wm, wn, l15, Q, acc);
  }
}

DI GA make_ga(const bf16* A, int lda, const bf16* Wt, int K, int N, bf16* o0, int ldc) {
  GA g; g.A = A; g.A2 = nullptr; g.lda = lda; g.ksplit = 0; g.mu = nullptr; g.Wt = Wt; g.K = K; g.N = N; g.o0 = o0; g.o1 = nullptr; g.ldc = ldc; g.act = 0; g.f0 = nullptr;
  return g;
}

DI void phase_attn(const Params& P, int j, int layer, char* smem, bool dry) {
  bf16* Qb = (bf16*)(WSP + OFF_BIG);
  const bf16* Kb = Qb + (size_t)M * D;
  const bf16* Vt = Kb + (size_t)M * D;
  constexpr int KBYTES = 64 * 272, VBYTES = 128 * 144, STAGE = KBYTES + VBYTES;
  const int tid = ltid(), lane = tid & 63, wave = tid >> 6, l15 = lane & 15, Q = lane >> 4;
  const float lam_init = 0.8f - 0.6f * expf(-0.3f * (float)layer);
  float lam;
  {
    const float* lp = IN(I_LAMBDA) + j * 256;
    float s1 = 0.f, s2 = 0.f;
    for (int i = 0; i < 64; ++i) { s1 += lp[i] * lp[64 + i]; s2 += lp[128 + i] * lp[192 + i]; }
    lam = expf(s1) - expf(s2) + lam_init;
  }
  const float* subln = IN(I_SUBLN) + j * 128;
  const int nitems = 2048 + 64;
  const int krow = tid >> 4, kc16 = tid & 15, vrow = tid >> 3, vc = tid & 7;
  for (int item = lbid(); item < nitems; item += gridDim.x) {
    int b, h, q0, nkv;
    if (item < 2048) {
      const int x = item & 7, i = item >> 3, pair = x * 4 + (i >> 6);
      b = pair >> 3; h = pair & 7; q0 = CL + (i & 63) * 128; nkv = 132;
    } else { const int it = item - 2048; b = it >> 4; h = (it >> 1) & 7; q0 = (it & 1) * 128; nkv = 4; }
    const size_t gb = (size_t)b * TB;
    const bf16* Kbase = Kb + gb * D + h * 128 + kc16 * 8;
    const bf16* Vbase = Vt + ((size_t)(b * 1024 + h * 128)) * TB + vc * 8;
    bf16x8 Qf[2][2][2];
#pragma unroll
    for (int qt = 0; qt < 2; ++qt)
#pragma unroll
      for (int m = 0; m < 2; ++m)
#pragma unroll
        for (int ks = 0; ks < 2; ++ks)
          Qf[qt][m][ks] = *(const bf16x8*)(Qb + (gb + q0 + wave * 32 + qt * 16 + l15) * D + h * 128 + m * 64 + ks * 32 + Q * 8);
    float mrun[2][2], lrun[2][2];
#pragma unroll
    for (int qt = 0; qt < 2; ++qt)
#pragma unroll
      for (int m = 0; m < 2; ++m) { mrun[qt][m] = 0.f; lrun[qt][m] = 0.f; }
    bf16x8 pk[4], pv[4];
    __syncthreads();
#pragma unroll
    for (int i = 0; i < 4; ++i) pk[i] = *(const bf16x8*)(Kbase + (size_t)(krow + 16 * i) * D);
#pragma unroll
    for (int i = 0; i < 4; ++i) *(bf16x8*)(smem + (krow + 16 * i) * 272 + kc16 * 16) = pk[i];
    __syncthreads();
#pragma unroll
    for (int m = 0; m < 2; ++m) {
      float mx0 = -3.0e38f, mx1 = -3.0e38f;
#pragma unroll
      for (int kt = 0; kt < 4; ++kt) {
        const bf16x8 k0 = *(const bf16x8*)(smem + (kt * 16 + l15) * 272 + (m * 64 + Q * 8) * 2);
        const bf16x8 k1 = *(const bf16x8*)(smem + (kt * 16 + l15) * 272 + (m * 64 + 32 + Q * 8) * 2);
        f32x4 t0 = f32x4{0.f, 0.f, 0.f, 0.f}, t1 = f32x4{0.f, 0.f, 0.f, 0.f};
        t0 = MFMA16(k0, Qf[0][m][0], t0); t0 = MFMA16(k1, Qf[0][m][1], t0);
        t1 = MFMA16(k0, Qf[1][m][0], t1); t1 = MFMA16(k1, Qf[1][m][1], t1);
        mx0 = fmaxf(fmaxf(mx0, fmaxf(t0[0], t0[1])), fmaxf(t0[2], t0[3]));
        mx1 = fmaxf(fmaxf(mx1, fmaxf(t1[0], t1[1])), fmaxf(t1[2], t1[3]));
      }
      mrun[0][m] = mx0 + 32.f; mrun[1][m] = mx1 + 32.f;
    }
    for (int kv = 0; kv < nkv; ++kv) {
      if (kv + 1 < nkv) {
#pragma unroll
        for (int i = 0; i < 4; ++i) pk[i] = *(const bf16x8*)(Kbase + (size_t)((kv + 1) * 64 + krow + 16 * i) * D);
      }
      const char* sK = smem + (kv & 1) * STAGE;
#pragma unroll
      for (int m = 0; m < 2; ++m) {
#pragma unroll
        for (int kt = 0; kt < 4; ++kt) {
          const bf16x8 k0 = *(const bf16x8*)(sK + (kt * 16 + l15) * 272 + (m * 64 + Q * 8) * 2);
          const bf16x8 k1 = *(const bf16x8*)(sK + (kt * 16 + l15) * 272 + (m * 64 + 32 + Q * 8) * 2);
#pragma unroll
          for (int qt = 0; qt < 2; ++qt) {
            const float nb = -mrun[qt][m];
            f32x4 t = f32x4{nb, nb, nb, nb};
            t = MFMA16(k0, Qf[qt][m][0], t);
            t = MFMA16(k1, Qf[qt][m][1], t);
            lrun[qt][m] += (__builtin_amdgcn_exp2f(t[0]) + __builtin_amdgcn_exp2f(t[1])) + (__builtin_amdgcn_exp2f(t[2]) + __builtin_amdgcn_exp2f(t[3]));
          }
        }
      }
      if (kv + 1 < nkv) {
        char* dK = smem + ((kv + 1) & 1) * STAGE;
#pragma unroll
        for (int i = 0; i < 4; ++i) *(bf16x8*)(dK + (krow + 16 * i) * 272 + kc16 * 16) = pk[i];
      }
      __syncthreads();
    }
    float Mx[2][2];
#pragma unroll
    for (int qt = 0; qt < 2; ++qt)
#pragma unroll
      for (int m = 0; m < 2; ++m) {
        float mm = mrun[qt][m], ll = lrun[qt][m];
#pragma unroll
        for (int o = 16; o <= 32; o <<= 1) {
          const float mo = __shfl_xor(mm, o), lo = __shfl_xor(ll, o);
          const float mn = fmaxf(mm, mo);
          ll = ll * __builtin_amdgcn_exp2f(mm - mn) + lo * __builtin_amdgcn_exp2f(mo - mn);
          mm = mn;
        }
        Mx[qt][m] = mm + __log2f(ll);
      }
    f32x4 O[2][8];
#pragma unroll
    for (int qt = 0; qt < 2; ++qt)
#pragma unroll
      for (int t = 0; t < 8; ++t) O[qt][t] = f32x4{0.f, 0.f, 0.f, 0.f};
#pragma unroll
    for (int i = 0; i < 4; ++i) {
      pk[i] = *(const bf16x8*)(Kbase + (size_t)(krow + 16 * i) * D);
      pv[i] = *(const bf16x8*)(Vbase + (size_t)(vrow + 32 * i) * TB);
    }
#pragma unroll
    for (int i = 0; i < 4; ++i) {
      *(bf16x8*)(smem + (krow + 16 * i) * 272 + kc16 * 16) = pk[i];
      *(bf16x8*)(smem + KBYTES + (vrow + 32 * i) * 144 + vc * 16) = pv[i];
    }
    __syncthreads();
    for (int kv = 0; kv < nkv; ++kv) {
      if (kv + 1 < nkv) {
#pragma unroll
        for (int i = 0; i < 4; ++i) {
          pk[i] = *(const bf16x8*)(Kbase + (size_t)((kv + 1) * 64 + krow + 16 * i) * D);
          pv[i] = *(const bf16x8*)(Vbase + (size_t)(vrow + 32 * i) * TB + (kv + 1) * 64);
        }
      }
      const char* sK = smem + (kv & 1) * STAGE;
      const char* sV = sK + KBYTES;
#pragma unroll
      for (int ks2 = 0; ks2 < 2; ++ks2) {
        bf16x8 Pf[2];
#pragma unroll
        for (int half = 0; half < 2; ++half) {
          const int kt = ks2 * 2 + half;
          f32x4 s[2][2];
#pragma unroll
          for (int m = 0; m < 2; ++m) {
            const bf16x8 k0 = *(const bf16x8*)(sK + (kt * 16 + l15) * 272 + (m * 64 + Q * 8) * 2);
            const bf16x8 k1 = *(const bf16x8*)(sK + (kt * 16 + l15) * 272 + (m * 64 + 32 + Q * 8) * 2);
#pragma unroll
            for (int qt = 0; qt < 2; ++qt) {
              const float nm = -Mx[qt][m];
              f32x4 t = f32x4{nm, nm, nm, nm};
              t = MFMA16(k0, Qf[qt][m][0], t);
              t = MFMA16(k1, Qf[qt][m][1], t);
              s[qt][m] = t;
            }
          }
#pragma unroll
          for (int qt = 0; qt < 2; ++qt)
#pragma unroll
            for (int r = 0; r < 4; ++r) {
              const float a = __builtin_amdgcn_exp2f(s[qt][0][r]) - lam * __builtin_amdgcn_exp2f(s[qt][1][r]);
              Pf[qt][half * 4 + r] = (short)f2bf(a);
            }
        }
        __builtin_amdgcn_s_setprio(1);
#pragma unroll
        for (int t = 0; t < 8; ++t) {
          const bf16x4 v0 = *(const bf16x4*)(sV + (t * 16 + l15) * 144 + (ks2 * 32 + Q * 4) * 2);
          const bf16x4 v1 = *(const bf16x4*)(sV + (t * 16 + l15) * 144 + (ks2 * 32 + 16 + Q * 4) * 2);
          const bf16x8 vf = __builtin_shufflevector(v0, v1, 0, 1, 2, 3, 4, 5, 6, 7);
#pragma unroll
          for (int qt = 0; qt < 2; ++qt) O[qt][t] = MFMA16(vf, Pf[qt], O[qt][t]);
        }
        __builtin_amdgcn_s_setprio(0);
      }
      if (kv + 1 < nkv) {
        char* dK = smem + ((kv + 1) & 1) * STAGE;
#pragma unroll
        for (int i = 0; i < 4; ++i) {
          *(bf16x8*)(dK + (krow + 16 * i) * 272 + kc16 * 16) = pk[i];
          *(bf16x8*)(dK + KBYTES + (vrow + 32 * i) * 144 + vc * 16) = pv[i];
        }
      }
      __syncthreads();
    }
    if (!dry) {
      float4 swv[8];
#pragma unroll
      for (int t = 0; t < 8; ++t) swv[t] = *(const float4*)(subln + t * 16 + Q * 4);
#pragma unroll
      for (int qt = 0; qt < 2; ++qt) {
        float ss = 0.f;
#pragma unroll
        for (int t = 0; t < 8; ++t)
#pragma unroll
          for (int r = 0; r < 4; ++r) ss += O[qt][t][r] * O[qt][t][r];
        ss += __shfl_xor(ss, 16);
        ss += __shfl_xor(ss, 32);
        const float rs = rsqrtf(ss * (1.f / 128.f) + 1e-5f) * (1.f - lam_init);
        bf16* dst = Qb + (gb + q0 + wave * 32 + qt * 16 + l15) * D + h * 128;
#pragma unroll
        for (int t = 0; t < 8; ++t) {
          const float4 sw = swv[t];
          bf16x4 o;
          o[0] = (short)f2bf(O[qt][t][0] * rs * sw.x); o[1] = (short)f2bf(O[qt][t][1] * rs * sw.y);
          o[2] = (short)f2bf(O[qt][t][2] * rs * sw.z); o[3] = (short)f2bf(O[qt][t][3] * rs * sw.w);
          *(bf16x4*)(dst + t * 16 + Q * 4) = o;
        }
      }
    }
  }
}

DI void phase_ssd_scan(const Params& P, int j, char* smem, int cu_idx, int nact) {
  float* sX = (float*)smem;
  float* sB = sX + 32 * 64;
  float* sC = sB + 32 * 128;
  float* sDt = sC + 32 * 128;
  float* sDA = sDt + 32;
  float* sY = sDA + 32;
  bf16* sRaw = (bf16*)(sY + 1024);
  const bf16* XS = (const bf16*)(WSP + OFF_Y);
  const bf16* BCb = (const bf16*)(WSP + OFF_BIG) + (size_t)4 * M * D;
  const float* DT = (const float*)(WSP + OFF_DT);
  bf16* Y0 = (bf16*)(WSP + OFF_H);
  bf16* Y1 = (bf16*)(WSP + OFF_BIG) + (size_t)M * D;
  const int tid = ltid(), prow = tid >> 3, nq = tid & 7;
  if (cu_idx < 0) return;
  for (int item = cu_idx; item < 256; item += nact) {
    const int chain = item >> 1, sp = item & 1;
    const int b = chain >> 5, dir = (chain >> 4) & 1, head = chain & 15, grp = head >> 3;
    const size_t gb = (size_t)b * TB;
    const float a_h = -expf(IN(I_ALOG)[(j * 2 + dir) * 16 + head]);
    const float dbias = IN(I_DTBIAS)[(j * 2 + dir) * 16 + head];
    const float dskip = dir == 0 ? IN(I_SSDD)[j * 16 + head] : 0.f;
    bf16* Yd = dir == 0 ? Y0 : Y1;
    const int myp = sp * 32 + prow;
    const int step = dir == 0 ? 1 : -1;
    float hst[16];
#pragma unroll
    for (int e = 0; e < 16; ++e) hst[e] = 0.f;
    bf16x8 pre[6];
    float predt = 0.f;
    auto issue = [&](int s0n) {
      const bool isctx = s0n < CL;
      const int pfirst = dir == 0 ? s0n : (isctx ? 255 - s0n : 8703 - s0n);
      const int seg_lo = isctx ? 0 : CL, seg_hi = isctx ? CL : TB;
      const int plo = dir == 0 ? pfirst : pfirst - 31;
#pragma unroll
      for (int r = 0; r < 6; ++r) {
        const int id = tid + 256 * r;
        pre[r] = bf16x8{0, 0, 0, 0, 0, 0, 0, 0};
        if (id < 1440) {
          const int rr = id / 40, cc = id - rr * 40;
          const int q = plo - 2 + rr;
          if (q >= seg_lo && q < seg_hi) {
            const bf16* src = cc < 8 ? XS + (gb + q) * 1024 + head * 64 + cc * 8
                                     : (cc < 24 ? BCb + (gb + q) * 512 + grp * 128 + (cc - 8) * 8 : BCb + (gb + q) * 512 + 256 + grp * 128 + (cc - 24) * 8);
            pre[r] = *(const bf16x8*)src;
          }
        }
      }
      if (tid < 32) predt = DT[(gb + pfirst + tid * step) * 32 + dir * 16 + head];
    };
    issue(0);
    for (int s0 = 0; s0 < TB; s0 += 32) {
      const bool isctx = s0 < CL;
      const int pfirst = dir == 0 ? s0 : (isctx ? 255 - s0 : 8703 - s0);
#pragma unroll
      for (int r = 0; r < 6; ++r) {
        const int id = tid + 256 * r;
        if (id < 1440) { const int rr = id / 40, cc = id - rr * 40; *(bf16x8*)(sRaw + rr * 328 + cc * 8) = pre[r]; }
      }
      if (tid < 32) { const float dt = softplusf(predt + dbias); sDt[tid] = dt; sDA[tid] = __expf(dt * a_h); }
      __syncthreads();
      if (s0 + 32 < TB) issue(s0 + 32);
      for (int u = tid; u < 640; u += 256) {
        const int c = u % 320, hf = u / 320;
        int ch; float* dstp; int dld;
        if (c < 64) { ch = head * 64 + c; dstp = sX + c; dld = 64; }
        else if (c < 192) { const int n = c - 64; ch = 1024 + grp * 128 + n; dstp = sB + n; dld = 128; }
        else { const int n = c - 192; ch = 1280 + grp * 128 + n; dstp = sC + n; dld = 128; }
        float raw[20];
#pragma unroll
        for (int i = 0; i < 20; ++i) raw[i] = bf2f(sRaw[(hf * 16 + i) * 328 + c]);
        const float* cw = IN(I_CONVW) + (size_t)j * 5 * 1536 + ch;
        const float w0 = cw[0], w1 = cw[1536], w2 = cw[2 * 1536], w3 = cw[3 * 1536], w4 = cw[4 * 1536];
        const float cbias = IN(I_CONVB)[j * 1536 + ch];
#pragma unroll
        for (int ii = 0; ii < 16; ++ii) {
          float v = cbias + w0 * raw[ii] + w1 * raw[ii + 1] + w2 * raw[ii + 2] + w3 * raw[ii + 3] + w4 * raw[ii + 4];
          v = v * __builtin_amdgcn_rcpf(1.f + __expf(-v));
          const int nl = hf * 16 + ii;
          const int li = dir == 0 ? nl : 31 - nl;
          dstp[li * dld] = v;
        }
      }
      __syncthreads();
      float4 bq[4], cq[4];
#pragma unroll
      for (int e = 0; e < 4; ++e) { bq[e] = *(const float4*)(sB + nq * 16 + e * 4); cq[e] = *(const float4*)(sC + nq * 16 + e * 4); }
      float xv = sX[myp], dt = sDt[0], dA = sDA[0];
#pragma unroll 2
      for (int i = 0; i < 32; ++i) {
        const int in = i < 31 ? i + 1 : 31;
        float4 nb[4], nc[4];
#pragma unroll
        for (int e = 0; e < 4; ++e) { nb[e] = *(const float4*)(sB + in * 128 + nq * 16 + e * 4); nc[e] = *(const float4*)(sC + in * 128 + nq * 16 + e * 4); }
        const float nxv = sX[in * 64 + myp], ndt = sDt[in], ndA = sDA[in];
        const float xdt = xv * dt;
        float pp[4];
#pragma unroll
        for (int e = 0; e < 4; ++e) {
          hst[4 * e + 0] = dA * hst[4 * e + 0] + xdt * bq[e].x; hst[4 * e + 1] = dA * hst[4 * e + 1] + xdt * bq[e].y;
          hst[4 * e + 2] = dA * hst[4 * e + 2] + xdt * bq[e].z; hst[4 * e + 3] = dA * hst[4 * e + 3] + xdt * bq[e].w;
          pp[e] = (cq[e].x * hst[4 * e + 0] + cq[e].y * hst[4 * e + 1]) + (cq[e].z * hst[4 * e + 2] + cq[e].w * hst[4 * e + 3]);
        }
        float part = (pp[0] + pp[1]) + (pp[2] + pp[3]);
        part = red8(part);
        if (nq == 0) sY[i * 32 + prow] = part + dskip * xv;
#pragma unroll
        for (int e = 0; e < 4; ++e) { bq[e] = nb[e]; cq[e] = nc[e]; }
        xv = nxv; dt = ndt; dA = ndA;
      }
      __syncthreads();
      {
        const int i = tid >> 3, r4 = (tid & 7) * 4;
        const int p = pfirst + i * step;
        bf16x4 o;
        o[0] = (short)f2bf(sY[i * 32 + r4]); o[1] = (short)f2bf(sY[i * 32 + r4 + 1]); o[2] = (short)f2bf(sY[i * 32 + r4 + 2]); o[3] = (short)f2bf(sY[i * 32 + r4 + 3]);
        *(bf16x4*)(Yd + (gb + p) * D + head * 64 + sp * 32 + r4) = o;
      }
    }
    __syncthreads();
  }
}

DI void phase_bcconv(const Params& P, int j) {
  const int lane = ltid() & 63;
  const int gw = lbid() * 4 + (ltid() >> 6), nw = gridDim.x * 4;
  const bf16* BCb = (const bf16*)(WSP + OFF_BIG) + (size_t)4 * M * D;
  bf16* BCc = (bf16*)(WSP + OFF_BIG) + (size_t)2 * M * D;
  const float* cw = IN(I_CONVW) + (size_t)j * 5 * 1536 + 1024 + lane * 8;
  const float* cb = IN(I_CONVB) + j * 1536 + 1024 + lane * 8;
  float w[5][8], bias[8];
#pragma unroll
  for (int t = 0; t < 5; ++t)
#pragma unroll
    for (int e = 0; e < 8; ++e) w[t][e] = cw[t * 1536 + e];
#pragma unroll
  for (int e = 0; e < 8; ++e) bias[e] = cb[e];
  for (int run = gw; run < M / 16; run += nw) {
    const int g0 = run * 16, b = g0 / TB, p0 = g0 - b * TB;
    const int seg_lo = p0 < CL ? 0 : CL, seg_hi = p0 < CL ? CL : TB;
    bf16x8 win[5];
#pragma unroll
    for (int t = 0; t < 4; ++t) {
      const int q = p0 - 2 + t;
      win[t + 1] = (q >= seg_lo && q < seg_hi) ? *(const bf16x8*)(BCb + ((size_t)b * TB + q) * 512 + lane * 8) : bf16x8{0, 0, 0, 0, 0, 0, 0, 0};
    }
#pragma unroll 4
    for (int i = 0; i < 16; ++i) {
#pragma unroll
      for (int t = 0; t < 4; ++t) win[t] = win[t + 1];
      const int q = p0 + i + 2;
      win[4] = (q < seg_hi) ? *(const bf16x8*)(BCb + ((size_t)b * TB + q) * 512 + lane * 8) : bf16x8{0, 0, 0, 0, 0, 0, 0, 0};
      bf16x8 o;
#pragma unroll
      for (int e = 0; e < 8; ++e) {
        float v = bias[e];
#pragma unroll
        for (int t = 0; t < 5; ++t) v += w[t][e] * bf2f((bf16)win[t][e]);
        v = v * __builtin_amdgcn_rcpf(1.f + __expf(-v));
        o[e] = (short)f2bf(v);
      }
      *(bf16x8*)(BCc + ((size_t)g0 + i) * 512 + lane * 8) = o;
    }
  }
}

DI void phase_ssd_chunk(const Params& P, int j, char* smem, int cu_idx, int nact) {
  bf16* sB = (bf16*)smem;
  bf16* sC = sB + 32 * 136;
  bf16* sBt = sC + 32 * 136;
  bf16* sXd = sBt + 128 * 40;
  bf16* sGm = sXd + 64 * 40;
  bf16* sH = sGm + 32 * 40;
  bf16* sXr = sH + 64 * 136;
  float* sDt = (float*)(sXr + 36 * 72);
  float* sAcs = sDt + 32;
  float* sScl = sAcs + 32;
  const bf16* XS = (const bf16*)(WSP + OFF_Y);
  const bf16* BCc = (const bf16*)(WSP + OFF_BIG) + (size_t)2 * M * D;
  const float* DT = (const float*)(WSP + OFF_DT);
  bf16* Y0 = (bf16*)(WSP + OFF_H);
  bf16* Y1 = (bf16*)(WSP + OFF_BIG) + (size_t)M * D;
  const int tid = ltid(), lane = tid & 63, wave = tid >> 6, l15 = lane & 15, Q = lane >> 4;
  if (cu_idx < 0) return;
  for (int item = cu_idx; item < 128; item += nact) {
    const int b = item >> 5, dir = (item >> 4) & 1, head = item & 15, grp = head >> 3;
    const size_t gb = (size_t)b * TB;
    const float a_h = -expf(IN(I_ALOG)[(j * 2 + dir) * 16 + head]);
    const float dbias = IN(I_DTBIAS)[(j * 2 + dir) * 16 + head];
    const float dskip = dir == 0 ? IN(I_SSDD)[j * 16 + head] : 0.f;
    bf16* Yd = dir == 0 ? Y0 : Y1;
    const int step = dir == 0 ? 1 : -1;
    const int cch = tid & 63, cq = tid >> 6;
    const float* cwp = IN(I_CONVW) + (size_t)j * 5 * 1536 + head * 64 + cch;
    const float w0 = cwp[0], w1 = cwp[1536], w2 = cwp[2 * 1536], w3 = cwp[3 * 1536], w4 = cwp[4 * 1536];
    const float cbias = IN(I_CONVB)[j * 1536 + head * 64 + cch];
    __syncthreads();
    for (int i = tid; i < 64 * 136 / 8; i += 256) *(bf16x8*)(sH + i * 8) = bf16x8{0, 0, 0, 0, 0, 0, 0, 0};
    f32x4 hacc[8];
#pragma unroll
    for (int t = 0; t < 8; ++t) hacc[t] = f32x4{0.f, 0.f, 0.f, 0.f};
    struct PF { bf16x8 px[2], pbc[4]; float predt; };
    PF pfa, pfb;
    pfa.predt = 0.f; pfb.predt = 0.f;
    auto issue = [&](PF& pf, int s0n) {
      const bool isctx = s0n < CL;
      const int pfirst = dir == 0 ? s0n : (isctx ? 255 - s0n : 8703 - s0n);
      const int seg_lo = isctx ? 0 : CL, seg_hi = isctx ? CL : TB;
      const int plo = dir == 0 ? pfirst : pfirst - 31;
#pragma unroll
      for (int r = 0; r < 2; ++r) {
        const int id = tid + 256 * r;
        pf.px[r] = bf16x8{0, 0, 0, 0, 0, 0, 0, 0};
        if (id < 288) {
          const int rr = id >> 3, cc = id & 7, q = plo - 2 + rr;
          if (q >= seg_lo && q < seg_hi) pf.px[r] = *(const bf16x8*)(XS + (gb + q) * 1024 + head * 64 + cc * 8);
        }
      }
#pragma unroll
      for (int r = 0; r < 4; ++r) {
        const int id = tid + 256 * r, li = id >> 5, cc = id & 31;
        const size_t gi = gb + pfirst + li * step;
        pf.pbc[r] = *(const bf16x8*)(BCc + gi * 512 + (cc < 16 ? grp * 128 + cc * 8 : 256 + grp * 128 + (cc - 16) * 8));
      }
      if (tid < 32) pf.predt = DT[(gb + pfirst + tid * step) * 32 + dir * 16 + head];
    };
    issue(pfa, 0);
    issue(pfb, 32);
    auto chunk = [&](int s0, PF& pf) {
      const bool isctx = s0 < CL;
      const int pfirst = dir == 0 ? s0 : (isctx ? 255 - s0 : 8703 - s0);
#pragma unroll
      for (int r = 0; r < 2; ++r) {
        const int id = tid + 256 * r;
        if (id < 288) *(bf16x8*)(sXr + (id >> 3) * 72 + (id & 7) * 8) = pf.px[r];
      }
#pragma unroll
      for (int r = 0; r < 4; ++r) {
        const int id = tid + 256 * r, li = id >> 5, cc = id & 31;
        if (cc < 16) *(bf16x8*)(sB + li * 136 + cc * 8) = pf.pbc[r];
        else *(bf16x8*)(sC + li * 136 + (cc - 16) * 8) = pf.pbc[r];
      }
      if (wave == 0) {
        const float xx = pf.predt + dbias, ex = __expf(xx);
        const float dt = xx > 20.f ? xx : (ex < 0.01f ? ex * (1.f - ex * (0.5f - ex * 0.33333334f)) : __logf(1.f + ex));
        float v = dt * a_h;
        v += __int_as_float(__builtin_amdgcn_update_dpp(0, __float_as_int(v), 0x111, 0xf, 0xf, true));
        v += __int_as_float(__builtin_amdgcn_update_dpp(0, __float_as_int(v), 0x112, 0xf, 0xf, true));
        v += __int_as_float(__builtin_amdgcn_update_dpp(0, __float_as_int(v), 0x114, 0xf, 0xf, true));
        v += __int_as_float(__builtin_amdgcn_update_dpp(0, __float_as_int(v), 0x118, 0xf, 0xf, true));
        const float r0 = __int_as_float(__builtin_amdgcn_readlane(__float_as_int(v), 15));
        if (lane >= 16) v += r0;
        const float lastv = __int_as_float(__builtin_amdgcn_readlane(__float_as_int(v), 31));
        if (lane < 32) { sDt[lane] = dt; sAcs[lane] = v; sScl[lane] = __expf(lastv - v); }
      }
      __syncthreads();
      if (s0 + 64 < TB) issue(pf, s0 + 64);
      const float acs_last = sAcs[31];
      {
        float raw[12];
#pragma unroll
        for (int i = 0; i < 12; ++i) raw[i] = bf2f(sXr[(cq * 8 + i) * 72 + cch]);
#pragma unroll
        for (int ii = 0; ii < 8; ++ii) {
          float v = cbias + w0 * raw[ii] + w1 * raw[ii + 1] + w2 * raw[ii + 2] + w3 * raw[ii + 3] + w4 * raw[ii + 4];
          v = v * __builtin_amdgcn_rcpf(1.f + __expf(-v));
          const int nl = cq * 8 + ii, li = dir == 0 ? nl : 31 - nl;
          sXd[cch * 40 + li] = f2bf(v * sDt[li]);
        }
#pragma unroll
        for (int e = 0; e < 2; ++e) {
          const int idx = tid + 256 * e, li = idx & 31, n8 = idx >> 5;
          const bf16x8 bv = *(const bf16x8*)(sB + li * 136 + n8 * 8);
          const float sc = sScl[li];
#pragma unroll
          for (int k = 0; k < 8; ++k) sBt[(n8 * 8 + k) * 40 + li] = f2bf(bf2f((bf16)bv[k]) * sc);
        }
      }
      {
        const int jt = wave >> 1, it = wave & 1;
        f32x4 acc = f32x4{0.f, 0.f, 0.f, 0.f};
        if (jt <= it) {
#pragma unroll
          for (int ks = 0; ks < 4; ++ks)
            acc = MFMA16(*(const bf16x8*)(sB + (16 * jt + l15) * 136 + 32 * ks + 8 * Q), *(const bf16x8*)(sC + (16 * it + l15) * 136 + 32 * ks + 8 * Q), acc);
        }
        const int i = 16 * it + l15;
        const float ai = sAcs[i];
        bf16x4 o;
#pragma unroll
        for (int r = 0; r < 4; ++r) {
          const int jx = 16 * jt + 4 * Q + r;
          float gv = (jx <= i) ? acc[r] * __expf(ai - sAcs[jx]) : 0.f;
          if (jx == i) gv += dskip / sDt[i];
          o[r] = (short)f2bf(gv);
        }
        *(bf16x4*)(sGm + i * 40 + 16 * jt + 4 * Q) = o;
      }
      __syncthreads();
      {
        const bf16x8 ax = *(const bf16x8*)(sXd + (16 * wave + l15) * 40 + 8 * Q);
#pragma unroll
        for (int it = 0; it < 2; ++it) {
          f32x4 accd = f32x4{0.f, 0.f, 0.f, 0.f}, acco = f32x4{0.f, 0.f, 0.f, 0.f};
          accd = MFMA16(ax, *(const bf16x8*)(sGm + (16 * it + l15) * 40 + 8 * Q), accd);
#pragma unroll
          for (int ks = 0; ks < 4; ++ks)
            acco = MFMA16(*(const bf16x8*)(sH + (16 * wave + l15) * 136 + 32 * ks + 8 * Q), *(const bf16x8*)(sC + (16 * it + l15) * 136 + 32 * ks + 8 * Q), acco);
          const int i = 16 * it + l15;
          const float ev = __expf(sAcs[i]);
          bf16x4 o;
#pragma unroll
          for (int r = 0; r < 4; ++r) o[r] = (short)f2bf(accd[r] + ev * acco[r]);
          *(bf16x4*)(Yd + (gb + pfirst + i * step) * D + head * 64 + 16 * wave + 4 * Q) = o;
        }
        const float dec = __expf(acs_last);
#pragma unroll
        for (int nt = 0; nt < 8; ++nt) {
          hacc[nt] = hacc[nt] * dec;
          hacc[nt] = MFMA16(*(const bf16x8*)(sBt + (16 * nt + l15) * 40 + 8 * Q), ax, hacc[nt]);
        }
      }
      __syncthreads();
#pragma unroll
      for (int nt = 0; nt < 8; ++nt) {
        bf16x4 o;
#pragma unroll
        for (int r = 0; r < 4; ++r) o[r] = (short)f2bf(hacc[nt][r]);
        *(bf16x4*)(sH + (16 * wave + l15) * 136 + 16 * nt + 4 * Q) = o;
      }
    };
    for (int s0 = 0; s0 < TB; s0 += 64) {
      chunk(s0, pfa);
      chunk(s0 + 32, pfb);
    }
    __syncthreads();
  }
}

DI void phase_ssd_out(const Params& P, int j) {
  const int lane = ltid() & 63;
  const int gw = lbid() * 4 + (ltid() >> 6), nw = gridDim.x * 4;
  const bf16* Y0 = (const bf16*)(WSP + OFF_H);
  const bf16* Y1 = (const bf16*)(WSP + OFF_BIG) + (size_t)M * D;
  bf16* Zb = (bf16*)(WSP + OFF_BIG) + (size_t)3 * M * D;
  const float* nwp = IN(I_SSDNORM) + j * 1024;
  for (int g = gw; g < M; g += nw) {
    const size_t base = (size_t)g * D + lane * 16;
    float yv[16]; float ss = 0.f;
#pragma unroll
    for (int hh = 0; hh < 2; ++hh) {
      const bf16x8 a = *(const bf16x8*)(Y0 + base + hh * 8), c = *(const bf16x8*)(Y1 + base + hh * 8), z = *(const bf16x8*)(Zb + base + hh * 8);
#pragma unroll
      for (int e = 0; e < 8; ++e) {
        const float v = (bf2f((bf16)a[e]) + bf2f((bf16)c[e])) * siluf(bf2f((bf16)z[e]));
        yv[hh * 8 + e] = v; ss += v * v;
      }
    }
#pragma unroll
    for (int o = 16; o >= 1; o >>= 1) ss += __shfl_xor(ss, o);
    const float rs = rsqrtf(ss * (1.f / 512.f) + 1e-5f);
#pragma unroll
    for (int hh = 0; hh < 2; ++hh) {
      bf16x8 o;
#pragma unroll
      for (int e = 0; e < 8; ++e) o[e] = (short)f2bf(yv[hh * 8 + e] * rs * nwp[lane * 16 + hh * 8 + e]);
      *(bf16x8*)(Zb + base + hh * 8) = o;
    }
  }
}

DI void phase_wkv_scan(const Params& P, int j, char* smem, int cu_idx, int nact) {
  float* sR = (float*)smem;
  float* sKK = sR + 2048;
  float* sW = sKK + 2048;
  float* sBv = sW + 2048;
  float* sKd = sBv + 2048;
  float* sV = sKd + 2048;
  float* sY = sV + 2048;
  float* sKKW = sY + 1024;
  float* sRKW = sKKW + 64;
  const bf16* R = (const bf16*)(WSP + OFF_BIG);
  const bf16* K = R + (size_t)M * D;
  const bf16* V = K + (size_t)M * D;
  const bf16* TW = (const bf16*)(WSP + OFF_TW);
  const bf16* TA = (const bf16*)(WSP + OFF_TA);
  float* RKo = (float*)(WSP + OFF_RK);
  bf16* Y0 = (bf16*)(WSP + OFF_H);
  bf16* Y1 = (bf16*)(WSP + OFF_Y);
  const int tid = ltid(), lane = tid & 63, wave = tid >> 6, l15 = lane & 15, Q = lane >> 4;
  const int prow = tid >> 3, kq = tid & 7;
  if (cu_idx < 0) return;
  for (int item = cu_idx; item < 256; item += nact) {
    const int chain = item >> 1, sp = item & 1;
    const int b = chain >> 5, dir = (chain >> 4) & 1, head = chain & 15;
    const size_t gb = (size_t)b * TB;
    bf16* Yd = dir == 0 ? Y0 : Y1;
    const int hc0 = head * 64;
    const int step = dir == 0 ? 1 : -1;
    bf16x8 Bw[2], Ba[2];
    {
      const float* w2 = IN(I_W2) + (size_t)(j * 2 + dir) * 64 * 1024 + hc0 + wave * 16 + l15;
      const float* a2 = IN(I_A2) + (size_t)(j * 2 + dir) * 64 * 1024 + hc0 + wave * 16 + l15;
#pragma unroll
      for (int ks = 0; ks < 2; ++ks)
#pragma unroll
        for (int jj = 0; jj < 8; ++jj) Bw[ks][jj] = (short)f2bf(w2[(size_t)(ks * 32 + Q * 8 + jj) * 1024]);
#pragma unroll
      for (int ks = 0; ks < 2; ++ks)
#pragma unroll
        for (int jj = 0; jj < 8; ++jj) Ba[ks][jj] = (short)f2bf(a2[(size_t)(ks * 32 + Q * 8 + jj) * 1024]);
    }
    bf16x8* sFr = (bf16x8*)(smem + 55296);
    sFr[tid] = Bw[0]; sFr[256 + tid] = Bw[1]; sFr[512 + tid] = Ba[0]; sFr[768 + tid] = Ba[1];
    const int ccol = hc0 + wave * 16 + l15;
    const float w0c = IN(I_W0)[(j * 2 + dir) * 1024 + ccol];
    const float a0c = IN(I_A0)[(j * 2 + dir) * 1024 + ccol];
    const float kac = IN(I_KA)[j * 1024 + ccol];
    const int myrow = sp * 32 + prow;
    const int ta_t = tid >> 3, ta_c8 = (tid & 7) * 8;
    __syncthreads();
    if (tid < 64) { sKKW[tid] = IN(I_KK)[j * 1024 + hc0 + tid]; sRKW[tid] = IN(I_RK)[j * 1024 + hc0 + tid]; }
    __syncthreads();
    float S[8] = {0.f, 0.f, 0.f, 0.f, 0.f, 0.f, 0.f, 0.f};
    bf16x8 prv, pkv, pvv, pfw[2][2], pfa[2][2];
    auto issue = [&](int s0n) {
      const bool isctx = s0n < CL;
      const int pfirst = dir == 0 ? s0n : (isctx ? 255 - s0n : 8703 - s0n);
      const size_t gi = gb + pfirst + ta_t * step;
      prv = *(const bf16x8*)(R + gi * D + hc0 + ta_c8);
      pkv = *(const bf16x8*)(K + gi * D + hc0 + ta_c8);
      pvv = *(const bf16x8*)(V + gi * D + hc0 + ta_c8);
#pragma unroll
      for (int mt = 0; mt < 2; ++mt) {
        const size_t g2 = gb + pfirst + (mt * 16 + l15) * step;
#pragma unroll
        for (int ks = 0; ks < 2; ++ks) {
          pfw[mt][ks] = *(const bf16x8*)(TW + g2 * 128 + dir * 64 + ks * 32 + Q * 8);
          pfa[mt][ks] = *(const bf16x8*)(TA + g2 * 128 + dir * 64 + ks * 32 + Q * 8);
        }
      }
    };
    issue(0);
    for (int s0 = 0; s0 < TB; s0 += 32) {
      const bool isctx = s0 < CL;
      const int pfirst = dir == 0 ? s0 : (isctx ? 255 - s0 : 8703 - s0);
      {
        float kk[8]; float ss = 0.f;
#pragma unroll
        for (int e = 0; e < 8; ++e) { kk[e] = bf2f((bf16)pkv[e]) * sKKW[ta_c8 + e]; ss += kk[e] * kk[e]; }
        ss = red8(ss);
        const float inv = fminf(__builtin_amdgcn_rsqf(ss), 1e12f);
#pragma unroll
        for (int e = 0; e < 8; ++e) {
          sR[ta_t * 64 + ta_c8 + e] = bf2f((bf16)prv[e]);
          sKd[ta_t * 64 + ta_c8 + e] = bf2f((bf16)pkv[e]);
          sKK[ta_t * 64 + ta_c8 + e] = kk[e] * inv;
          sV[ta_t * 64 + ta_c8 + e] = bf2f((bf16)pvv[e]);
        }
      }
      f32x4 aw[2], aa[2];
#pragma unroll
      for (int mt = 0; mt < 2; ++mt) {
        aw[mt] = f32x4{0.f, 0.f, 0.f, 0.f}; aa[mt] = f32x4{0.f, 0.f, 0.f, 0.f};
#pragma unroll
        for (int ks = 0; ks < 2; ++ks) {
          aw[mt] = MFMA16(pfw[mt][ks], sFr[ks * 256 + tid], aw[mt]);
          aa[mt] = MFMA16(pfa[mt][ks], sFr[512 + ks * 256 + tid], aa[mt]);
        }
      }
      __syncthreads();
      if (s0 + 32 < TB) issue(s0 + 32);
#pragma unroll
      for (int mt = 0; mt < 2; ++mt)
#pragma unroll
        for (int r = 0; r < 4; ++r) {
          const int t = mt * 16 + Q * 4 + r, idx = t * 64 + wave * 16 + l15;
          const float wl = w0c + aw[mt][r];
          const float ee = 0.6065306597f * __builtin_amdgcn_rcpf(1.f + __expf(-wl));
          const float a = __builtin_amdgcn_rcpf(1.f + __expf(-(a0c + aa[mt][r])));
          const float kraw = sKd[idx], kk = sKK[idx];
          sW[idx] = __expf(-ee);
          sBv[idx] = kk * a;
          sKd[idx] = kraw * (1.f + (a - 1.f) * kac);
          sKK[idx] = -kk;
        }
      __syncthreads();
      if (sp == 0) {
        float s = 0.f;
#pragma unroll
        for (int e = 0; e < 8; ++e) s += sR[ta_t * 64 + ta_c8 + e] * sRKW[ta_c8 + e] * sKd[ta_t * 64 + ta_c8 + e];
        s = red8(s);
        if ((tid & 7) == 0) RKo[(gb + pfirst + ta_t * step) * 32 + dir * 16 + head] = s;
      }
      struct OPS { float4 nk0, nk1, wv0, wv1, bv0, bv1, kd0, kd1, rr0, rr1; float vv; };
      OPS oa, ob;
#define WKV_LOAD(o, ii) do { const int in_ = (ii) < 32 ? (ii) : 31; \
        (o).nk0 = *(const float4*)(sKK + in_ * 64 + kq * 8); (o).nk1 = *(const float4*)(sKK + in_ * 64 + kq * 8 + 4); \
        (o).wv0 = *(const float4*)(sW + in_ * 64 + kq * 8);  (o).wv1 = *(const float4*)(sW + in_ * 64 + kq * 8 + 4); \
        (o).bv0 = *(const float4*)(sBv + in_ * 64 + kq * 8); (o).bv1 = *(const float4*)(sBv + in_ * 64 + kq * 8 + 4); \
        (o).kd0 = *(const float4*)(sKd + in_ * 64 + kq * 8); (o).kd1 = *(const float4*)(sKd + in_ * 64 + kq * 8 + 4); \
        (o).rr0 = *(const float4*)(sR + in_ * 64 + kq * 8);  (o).rr1 = *(const float4*)(sR + in_ * 64 + kq * 8 + 4); \
        (o).vv = sV[in_ * 64 + myrow]; } while (0)
#define WKV_STEP(o, ii) do { \
        float sa = ((S[0] * (o).nk0.x + S[1] * (o).nk0.y) + (S[2] * (o).nk0.z + S[3] * (o).nk0.w)) + ((S[4] * (o).nk1.x + S[5] * (o).nk1.y) + (S[6] * (o).nk1.z + S[7] * (o).nk1.w)); \
        sa = red8(sa); \
        S[0] = S[0] * (o).wv0.x + (sa * (o).bv0.x + (o).vv * (o).kd0.x); S[1] = S[1] * (o).wv0.y + (sa * (o).bv0.y + (o).vv * (o).kd0.y); \
        S[2] = S[2] * (o).wv0.z + (sa * (o).bv0.z + (o).vv * (o).kd0.z); S[3] = S[3] * (o).wv0.w + (sa * (o).bv0.w + (o).vv * (o).kd0.w); \
        S[4] = S[4] * (o).wv1.x + (sa * (o).bv1.x + (o).vv * (o).kd1.x); S[5] = S[5] * (o).wv1.y + (sa * (o).bv1.y + (o).vv * (o).kd1.y); \
        S[6] = S[6] * (o).wv1.z + (sa * (o).bv1.z + (o).vv * (o).kd1.z); S[7] = S[7] * (o).wv1.w + (sa * (o).bv1.w + (o).vv * (o).kd1.w); \
        float y = ((S[0] * (o).rr0.x + S[1] * (o).rr0.y) + (S[2] * (o).rr0.z + S[3] * (o).rr0.w)) + ((S[4] * (o).rr1.x + S[5] * (o).rr1.y) + (S[6] * (o).rr1.z + S[7] * (o).rr1.w)); \
        y = red8(y); \
        if (kq == 0) sY[(ii) * 32 + prow] = y; } while (0)
      WKV_LOAD(oa, 0);
#pragma unroll 2
      for (int i = 0; i < 32; i += 2) {
        WKV_LOAD(ob, i + 1);
        WKV_STEP(oa, i);
        WKV_LOAD(oa, i + 2);
        WKV_STEP(ob, i + 1);
      }
#undef WKV_LOAD
#undef WKV_STEP
      __syncthreads();
      {
        const int i = tid >> 3, r4 = (tid & 7) * 4;
        const int p = pfirst + i * step;
        bf16x4 o;
        o[0] = (short)f2bf(sY[i * 32 + r4]); o[1] = (short)f2bf(sY[i * 32 + r4 + 1]); o[2] = (short)f2bf(sY[i * 32 + r4 + 2]); o[3] = (short)f2bf(sY[i * 32 + r4 + 3]);
        *(bf16x4*)(Yd + (gb + p) * D + hc0 + sp * 32 + r4) = o;
      }
    }
    __syncthreads();
  }
}

DI void phase_wkv_out(const Params& P, int j) {
  const int lane = ltid() & 63;
  const int gw = lbid() * 4 + (ltid() >> 6), nw = gridDim.x * 4;
  const bf16* Y0 = (const bf16*)(WSP + OFF_H);
  const bf16* Y1 = (const bf16*)(WSP + OFF_Y);
  bf16* R = (bf16*)(WSP + OFF_BIG);
  const bf16* V = R + (size_t)2 * M * D;
  const float* RKi = (const float*)(WSP + OFF_RK);
  const float* lnw = IN(I_LNW) + j * 1024;
  const float* lnb = IN(I_LNB) + j * 1024;
  for (int g = gw; g < M; g += nw) {
    const size_t base = (size_t)g * D + lane * 16;
    const int head = lane >> 2;
    float yv[16], vv[16]; float s = 0.f;
#pragma unroll
    for (int hh = 0; hh < 2; ++hh) {
      const bf16x8 a = *(const bf16x8*)(Y0 + base + hh * 8), c = *(const bf16x8*)(Y1 + base + hh * 8), v = *(const bf16x8*)(V + base + hh * 8);
#pragma unroll
      for (int e = 0; e < 8; ++e) { yv[hh * 8 + e] = bf2f((bf16)a[e]) + bf2f((bf16)c[e]); vv[hh * 8 + e] = bf2f((bf16)v[e]); s += yv[hh * 8 + e]; }
    }
    s = red4(s);
    const float mean = s * (1.f / 64.f);
    float q = 0.f;
#pragma unroll
    for (int e = 0; e < 16; ++e) { const float d = yv[e] - mean; q += d * d; }
    q = red4(q);
    const float rs = rsqrtf(q * (1.f / 64.f) + 64e-5f);
    const float rk = RKi[(size_t)g * 32 + head] + RKi[(size_t)g * 32 + 16 + head];
#pragma unroll
    for (int hh = 0; hh < 2; ++hh) {
      bf16x8 o;
#pragma unroll
      for (int e = 0; e < 8; ++e) {
        const int c = lane * 16 + hh * 8 + e;
        o[e] = (short)f2bf((yv[hh * 8 + e] - mean) * rs * lnw[c] + lnb[c] + rk * vv[hh * 8 + e]);
      }
      *(bf16x8*)(R + base + hh * 8) = o;
    }
  }
}

#define XB_TMO      128
#define XB_XCNT(j)  (256  + 64 * (j))
#define XB_XSUB(j)  (1280 + 64 * (j))
#define XB_XGEN(j)  (2304 + 64 * (j))
#define XB_TOP      3328
#define XB_TOPGEN   3392
#define XCD_BAR_WORDS 3456
#define XB_SPIN_CAP (1u << 23)
#define LAS __attribute__((address_space(3)))

__device__ __forceinline__ unsigned xb_ld(unsigned* p)              { return __hip_atomic_load(p, __ATOMIC_RELAXED, __HIP_MEMORY_SCOPE_AGENT); }
__device__ __forceinline__ unsigned xb_add(unsigned* p, unsigned v) { return __hip_atomic_fetch_add(p, v, __ATOMIC_RELAXED, __HIP_MEMORY_SCOPE_AGENT); }
__device__ __forceinline__ unsigned xb_xcc_id() { return (unsigned)__builtin_amdgcn_s_getreg((3 << 11) | 20) & 0xFu; }
#define XB_SPIN(cond, bar) do { unsigned _sp = 0; while (cond) { __builtin_amdgcn_s_sleep(1); \
    if ((++_sp & 255u) == 0u) { if (xb_ld(&(bar)[XB_TMO])) break; if (_sp > XB_SPIN_CAP) { atomicAdd(&(bar)[XB_TMO], 1u); break; } } } } while (0)

struct XcdBarrier {
    unsigned* bar; unsigned x;
    volatile LAS unsigned* st;
};

__device__ __forceinline__ XcdBarrier xcd_barrier_post(unsigned* bar, volatile LAS unsigned* st) {
    XcdBarrier b; b.bar = bar; b.x = xb_xcc_id(); b.st = st;
    if (threadIdx.x == 0) (void)xb_add(&bar[XB_XCNT(b.x)], 1u);
    return b;
}
__device__ __forceinline__ void xcd_barrier_complete(unsigned* bar, unsigned x, unsigned& nloc, unsigned& nx) {
    const unsigned G = gridDim.x * gridDim.y * gridDim.z;
    unsigned sum, cnt, mine, sp = 0u;
    for (;;) {
        sum = 0u; cnt = 0u; mine = 0u;
#pragma unroll
        for (unsigned j = 0; j < 16; ++j) { const unsigned c = xb_ld(&bar[XB_XCNT(j)]); sum += c; cnt += (c > 0u) ? 1u : 0u; mine = (j == x) ? c : mine; }
        if (sum == G) break;
        __builtin_amdgcn_s_sleep(1);
        if ((++sp & 255u) == 0u) { if (xb_ld(&bar[XB_TMO])) break; if (sp > XB_SPIN_CAP) { atomicAdd(&bar[XB_TMO], 1u); break; } }
    }
    nloc = mine > 0u ? mine : 1u; nx = cnt > 0u ? cnt : 1u;
}

__device__ __forceinline__ void xcd_barrier(const XcdBarrier& b) {
    asm volatile("s_waitcnt vmcnt(0)" ::: "memory");
    __syncthreads();
    if (threadIdx.x == 0) {
        unsigned* bar = b.bar;
        __builtin_amdgcn_s_waitcnt(0);
        unsigned nloc = b.st[0], nx = b.st[1];
        if (nloc == 0u) { xcd_barrier_complete(bar, b.x, nloc, nx); b.st[0] = nloc; b.st[1] = nx; }
        const unsigned old = xb_add(&bar[XB_XSUB(b.x)], 1u);
        const unsigned gen = old / nloc;
        if (old + 1u == (gen + 1u) * nloc) {
            __builtin_amdgcn_fence(__ATOMIC_RELEASE, "agent");
            asm volatile("s_waitcnt vmcnt(0)" ::: "memory");
            const unsigned og = xb_add(&bar[XB_TOP], 1u);
            const unsigned tg = og / nx;
            if (og + 1u == (tg + 1u) * nx) xb_add(&bar[XB_TOPGEN], 1u);
            else XB_SPIN(xb_ld(&bar[XB_TOPGEN]) == tg, bar);
            __builtin_amdgcn_fence(__ATOMIC_ACQUIRE, "agent");
            xb_add(&bar[XB_XGEN(b.x)], 1u);
            asm volatile("s_waitcnt vmcnt(0)" ::: "memory");
        } else {
            XB_SPIN(xb_ld(&bar[XB_XGEN(b.x)]) == gen, bar);
            __builtin_amdgcn_fence(__ATOMIC_ACQUIRE, "agent");
            asm volatile("s_waitcnt vmcnt(0)" ::: "memory");
        }
    }
    __syncthreads();
}


enum { OP_NOP = 0, OP_INIT, OP_CONVERT, OP_POSTPRE, OP_FFN_IN, OP_FFN_OUT, OP_EVENIN, OP_ATTN, OP_SSD, OP_SSDOUT, OP_EVENOUT,
       OP_MIX, OP_VMIX, OP_WKV, OP_WKVOUT, OP_GMUL, OP_WO, OP_BCCONV };
enum { KG_NONE = 0, KG_SWIGLU, KG_STORE, KG_EVENIN, KG_MIX, KG_MIXS, KG_VMIX, KG_GMUL };

__global__ void __launch_bounds__(256, 2) mega_kernel(Params P0) {
  cg::grid_group grid = cg::this_grid();
  __shared__ __attribute__((aligned(16))) char smem[73728];
  __shared__ Params sP;
  if (threadIdx.x < 40) sP.in[threadIdx.x] = P0.in[threadIdx.x];
  if (threadIdx.x == 40) sP.xlat = P0.xlat;
  if (threadIdx.x == 41) sP.ws = P0.ws;
  __shared__ uint4 xb_words;
  if (threadIdx.x == 0) xb_words = make_uint4(0u, 0u, 0u, 0u);
  __syncthreads();
  XcdBarrier xb = xcd_barrier_post((unsigned*)(P0.ws + OFF_BAR), (volatile LAS unsigned*)&xb_words);
  __shared__ int s_cu_idx, s_r1_idx;
  if (threadIdx.x == 0) {
    unsigned* tab = (unsigned*)(P0.ws + OFF_CENSUS);
    const unsigned hw = (unsigned)__builtin_amdgcn_s_getreg((15 << 11) | 4);
    const unsigned key = xb_xcc_id() * 256u + ((hw >> 8) & 0xFFu);
    const unsigned r = xb_add(&tab[key], 1u);
    s_cu_idx = (r == 0u) ? (int)xb_add(&tab[2048], 1u) : -1;
    s_r1_idx = (r == 0u) ? -1 : (int)xb_add(&tab[2049], 1u);
  }
  __syncthreads();
  const Params& P = sP;
#pragma unroll 1
  for (int pc = -3; pc < 80; ++pc) {
    bf16* H = (bf16*)(WSP + OFF_H);
    bf16* Y = (bf16*)(WSP + OFF_Y);
    bf16* BIG = (bf16*)(WSP + OFF_BIG);
    const bf16* W = (const bf16*)(WSP + OFF_W) + (size_t)((pc < 0 ? 0 : pc / 20) & 1) * W_STRIDE;
    int op = OP_NOP, arg = 0, sync = 0, l = 0;
    if (pc == -3) { op = OP_INIT; sync = 1; }
    else if (pc == -2) { op = OP_CONVERT; arg = 0; }
    else if (pc == -1) { op = OP_POSTPRE; arg = 3; sync = 1; }
    else {
      l = pc / 20;
      const int s = pc - l * 20;
      const bool odd = (l & 1) != 0;
      const int j = l >> 1;
      if (s == 0) { op = OP_FFN_IN; arg = 0; sync = 1; }
      else if (s == 1) { op = OP_FFN_OUT; arg = 0; sync = 1; }
      else if (s == 2) { op = OP_POSTPRE; arg = 0; sync = 1; }
      else if (s <= 14) {
        if (!odd) {
          if (s == 3) { op = OP_EVENIN; sync = 1; } else if (s == 4) { op = OP_ATTN; sync = 1; } else if (s == 5) { op = OP_BCCONV; sync = 1; }
          else if (s == 6) { op = OP_SSD; sync = 1; } else if (s == 7) { op = OP_SSDOUT; sync = 1; } else if (s == 8) { op = OP_EVENOUT; sync = 1; }
        } else {
          if (s <= 9) { op = OP_MIX; arg = s - 3; sync = (s == 9); if (arg == 6 && j == 0) op = OP_NOP; }
          else if (s == 10) { if (j > 0) { op = OP_VMIX; sync = 1; } }
          else if (s == 11) { op = OP_WKV; sync = 1; } else if (s == 12) { op = OP_WKVOUT; sync = 1; }
          else if (s == 13) { op = OP_GMUL; sync = 1; } else { op = OP_WO; sync = 1; }
        }
      }
      else if (s == 15) { op = OP_POSTPRE; arg = 1; sync = 1; }
      else if (s == 16) { op = OP_FFN_IN; arg = 1; sync = 1; }
      else if (s == 17) { op = OP_FFN_OUT; arg = 1; sync = 1; }
      else if (s == 18) { }
      else { op = OP_POSTPRE; arg = 2; sync = 1; }
    }
    const int j = l >> 1;
#ifndef PROBE_DUP
#define PROBE_DUP 0
#endif
    const int reps = ((PROBE_DUP >> op) & 1) ? 2 : 1;
#pragma unroll 1
    for (int rep = 0; rep < reps; ++rep) {
    GA g = make_ga(H, 1024, W, 1024, 1024, Y, 1024);
    int kind = KG_NONE;
    switch (op) {
      case OP_INIT: phase_init(P, smem); break;
      case OP_CONVERT: phase_convert(P, arg, lbid(), gridDim.x); break;
      case OP_POSTPRE:
        if (arg == 3) phase_postpre(P, false, 0, 0, 0.f, true, 0, 0);
        else if (arg == 0) phase_postpre(P, true, l, 0, 0.5f, true, l, 1);
        else if (arg == 1) phase_postpre(P, true, l, 1, 1.0f, true, l, 2);
        else phase_postpre(P, true, l, 2, 0.5f, l < 3, l + 1, 0);
        break;
      case OP_FFN_IN: g = make_ga(H, 1024, W + (arg ? W_FIN1 : W_FIN0), 1024, 5632, BIG, FH); kind = KG_SWIGLU; break;
      case OP_FFN_OUT: g = make_ga(BIG, FH, W + (arg ? W_FOUT1 : W_FOUT0), FH, 1024, Y, 1024); kind = KG_STORE; break;
      case OP_EVENIN: g = make_ga(H, 1024, W + W_EIN, 1024, 5888, nullptr, 0); kind = KG_EVENIN; break;
      case OP_ATTN: phase_attn(P, j, l, smem, rep + 1 < reps); break;
      case OP_SSD: {
        const int nact = (int)xb_ld((unsigned*)(WSP + OFF_CENSUS) + 2048), nr1 = (int)gridDim.x - nact, nit = nact < 128 ? nact : 128;
        const bool scanner = s_cu_idx >= 0 && s_cu_idx < 128;
        const int ncv = (int)gridDim.x - nit;
        if (scanner) phase_ssd_chunk(P, j, smem, s_cu_idx, nit);
        if (l < 3 && (!scanner || ncv == 0))
          phase_convert(P, l + 1, ncv == 0 ? lbid() : (s_cu_idx < 0 ? s_r1_idx : nr1 + s_cu_idx - 128), ncv == 0 ? (int)gridDim.x : ncv);
      } break;
      case OP_BCCONV: phase_bcconv(P, j); break;
      case OP_SSDOUT: phase_ssd_out(P, j); break;
      case OP_EVENOUT: g = make_ga(BIG, 1024, W + W_EOUT, 2048, 1024, Y, 1024); g.A2 = BIG + (size_t)3 * M * D; g.ksplit = 1024; kind = KG_STORE; break;
      case OP_MIX: {
        const float* mu = IN(I_MU) + (size_t)j * 6 * 1024;
        bf16* R = BIG; bf16* K = BIG + (size_t)M * D; bf16* V = BIG + (size_t)2 * M * D;
        if (arg == 0) { g = make_ga(H, 1024, W + W_R, 1024, 1024, R, 1024); g.mu = mu; }
        else if (arg == 1) { g = make_ga(H, 1024, W + W_K, 1024, 1024, K, 1024); g.mu = mu + 2 * 1024; }
        else if (arg == 2) { g = make_ga(H, 1024, W + W_V, 1024, 1024, V, 1024); g.mu = mu + 3 * 1024; if (j == 0) g.o1 = (bf16*)(WSP + OFF_VF); }
        else if (arg == 3) { g = make_ga(H, 1024, W + W_W1, 1024, 128, (bf16*)(WSP + OFF_TW), 128); g.mu = mu + 1 * 1024; g.act = 1; }
        else if (arg == 4) { g = make_ga(H, 1024, W + W_A1, 1024, 128, (bf16*)(WSP + OFF_TA), 128); g.mu = mu + 4 * 1024; }
        else if (arg == 5) { g = make_ga(H, 1024, W + W_G1, 1024, 160, (bf16*)(WSP + OFF_TG), 160); g.mu = mu + 5 * 1024; g.act = 2; }
        else { g = make_ga(H, 1024, W + W_V1, 1024, 32, (bf16*)(WSP + OFF_TV), 32); g.mu = mu + 3 * 1024; }
        kind = KG_MIXS;
      } break;
      case OP_VMIX: g = make_ga((bf16*)(WSP + OFF_TV), 32, W + W_V2, 32, 1024, BIG + (size_t)2 * M * D, 1024); g.f0 = IN(I_V0) + (size_t)(j - 1) * 1024; kind = KG_VMIX; break;
      case OP_WKV: {
        const int nact = (int)xb_ld((unsigned*)(WSP + OFF_CENSUS) + 2048), nr1 = (int)gridDim.x - nact, nit = nact < 256 ? nact : 256;
        const bool scanner = s_cu_idx >= 0 && s_cu_idx < 256;
        const int ncv = (int)gridDim.x - nit;
        if (scanner) phase_wkv_scan(P, j, smem, s_cu_idx, nit);
        if (l < 3 && (!scanner || ncv == 0))
          phase_convert(P, l + 1, ncv == 0 ? lbid() : (s_cu_idx < 0 ? s_r1_idx : nr1 + s_cu_idx - 256), ncv == 0 ? (int)gridDim.x : ncv);
      } break;
      case OP_WKVOUT: phase_wkv_out(P, j); break;
      case OP_GMUL: g = make_ga((bf16*)(WSP + OFF_TG), 160, W + W_G2, 160, 1024, BIG, 1024); kind = KG_GMUL; break;
      case OP_WO: g = make_ga(BIG, 1024, W + W_O, 1024, 1024, Y, 1024); kind = KG_STORE; break;
      default: break;
    }
    switch (kind) {
      case KG_SWIGLU: gemm_phase<32, 0, EPI_SWIGLU, 8>(P, g, smem); break;
      case KG_STORE: gemm_phase<64, 0, EPI_STORE, 4>(P, g, smem); break;
      case KG_EVENIN: gemm_phase<64, 0, EPI_EVENIN, 4>(P, g, smem); break;

      case KG_MIXS: gemm_phase<64, 1, EPI_STORE, 4>(P, g, smem); break;
      case KG_VMIX: gemm_phase<32, 0, EPI_VMIX, 8>(P, g, smem); break;
      case KG_GMUL: gemm_phase<32, 0, EPI_GMUL, 8>(P, g, smem); break;
      default: break;
    }
    if (sync || rep + 1 < reps) { if (pc == -3) grid.sync(); else xcd_barrier(xb); }
    }
  }
}

extern "C" void kernel_launch(void* const* d_in, const int* in_sizes, int n_in, void* d_out, int out_size, void* d_ws, size_t ws_size,
                              hipStream_t stream) {
  static int grid_blocks = 0;
  if (!grid_blocks) {
    int dev = 0, cus = 0, per_cu = 0;
    hipGetDevice(&dev);
    hipDeviceGetAttribute(&cus, hipDeviceAttributeMultiprocessorCount, dev);
    hipOccupancyMaxActiveBlocksPerMultiprocessor(&per_cu, mega_kernel, 256, 0);
    if (per_cu > 2) per_cu = 2;
    if (per_cu < 1) per_cu = 1;
    grid_blocks = cus * per_cu;
  }
  if (ws_size < WS_NEED) fprintf(stderr, "workspace too small: %zu < %zu\n", ws_size, (size_t)WS_NEED);
  Params p;
  memset(&p, 0, sizeof(p));
  for (int i = 0; i < 40; ++i) p.in[i] = (const float*)d_in[i];
  p.xlat = (float*)d_out;
  p.ws = (char*)d_ws;
  hipMemsetAsync((char*)d_ws + OFF_BAR, 0, 32768, stream);
  void* args[] = {&p};
  hipError_t e = hipLaunchCooperativeKernel((void*)mega_kernel, dim3(grid_blocks), dim3(256), args, 0, stream);
  if (e != hipSuccess) fprintf(stderr, "cooperative launch failed: %s (grid %d)\n", hipGetErrorString(e), grid_blocks);
}
```

```cpp
#include <hip/hip_runtime.h>
#include <hip/hip_cooperative_groups.h>
#include <cstdio>
#include <cstring>
#include <cstdint>
namespace cg = cooperative_groups;

typedef unsigned short bf16;
using bf16x8 = __attribute__((ext_vector_type(8))) short;
using bf16x4 = __attribute__((ext_vector_type(4))) short;
using f32x4 = __attribute__((ext_vector_type(4))) float;
#define DI __device__ __forceinline__

constexpr int D = 1024, NB = 4, CL = 256, TB = 8448, M = 33792, FH = 2816;
constexpr size_t U = (size_t)M * D * 2;

constexpr size_t OFF_H = 0;
constexpr size_t OFF_Y = U;
constexpr size_t OFF_BIG = 2 * U;
constexpr size_t OFF_VF = OFF_BIG + 4 * U + U / 2;
constexpr size_t OFF_W = OFF_VF + U;
constexpr size_t W_STRIDE = 25432064;
constexpr size_t W_ELEMS = 2 * W_STRIDE;
constexpr size_t OFF_TW = OFF_W + W_ELEMS * 2;
constexpr size_t OFF_TA = OFF_TW + (size_t)M * 128 * 2;
constexpr size_t OFF_TG = OFF_TA + (size_t)M * 128 * 2;
constexpr size_t OFF_TV = OFF_TG + (size_t)M * 160 * 2;
constexpr size_t OFF_DT = OFF_TV + (size_t)M * 32 * 2;
constexpr size_t OFF_RK = OFF_DT + (size_t)M * 32 * 4;
constexpr size_t OFF_XCTX = OFF_RK + (size_t)M * 32 * 4;
constexpr size_t OFF_MOD = OFF_XCTX + (size_t)NB * CL * D * 4;
constexpr size_t OFF_ROPE = OFF_MOD + (size_t)4 * 5 * 9216 * 4;
constexpr size_t OFF_BAR = OFF_ROPE + (size_t)128 * 16 * 2 * 4;
constexpr size_t OFF_CENSUS = OFF_BAR + 16384;
constexpr size_t WS_NEED = OFF_CENSUS + 16384;

constexpr size_t W_FIN0 = 0, W_FOUT0 = 5767168, W_FIN1 = 8650752, W_FOUT1 = 14417920, W_MIX = 17301504;
constexpr size_t W_EIN = W_MIX, W_EOUT = W_MIX + 6029312;
constexpr size_t W_R = W_MIX, W_K = W_R + 1048576, W_V = W_K + 1048576, W_O = W_V + 1048576, W_W1 = W_O + 1048576,
                 W_A1 = W_W1 + 131072, W_G1 = W_A1 + 131072, W_V1 = W_G1 + 163840, W_G2 = W_V1 + 32768, W_V2 = W_G2 + 163840;

struct Params {
  const float* in[40];
  float* xlat;
  char* ws;
};

enum { I_X = 0, I_C, I_CTX, I_CCTX, I_ADAW, I_ADAB, I_NORMW, I_FWIN, I_FWOUT, I_EWIN, I_EWOUT, I_LAMBDA, I_SUBLN, I_CONVW, I_CONVB,
       I_DTBIAS, I_ALOG, I_SSDD, I_SSDNORM, I_MU, I_WR, I_WK, I_WV, I_WO, I_W0, I_W1, I_W2, I_A0, I_A1, I_A2, I_G1, I_G2,
       I_KK, I_KA, I_RK, I_LNW, I_LNB, I_V0, I_V1, I_V2 };

DI const void* rfl_ptr(const void* p) {
  unsigned lo = (unsigned)(size_t)p, hi = (unsigned)((size_t)p >> 32);
  lo = __builtin_amdgcn_readfirstlane(lo); hi = __builtin_amdgcn_readfirstlane(hi);
  return (const void*)(__attribute__((address_space(1))) const char*)(((size_t)hi << 32) | (size_t)lo);
}
#define IN(i) ((const float*)rfl_ptr((const void*)P.in[i]))
#define WSP ((char*)rfl_ptr((const void*)P.ws))
#define XLATP ((float*)rfl_ptr((const void*)P.xlat))
DI int ltid() { int t = threadIdx.x; asm volatile("" : "+v"(t)); return t; }
DI int lbid() { int t = blockIdx.x; asm volatile("" : "+s"(t)); return t; }
DI bf16 f2bf(float x) { __bf16 r = (__bf16)x; return __builtin_bit_cast(unsigned short, r); }
DI float bf2f(bf16 v) { return __uint_as_float(((unsigned)v) << 16); }
DI float siluf(float x) { return x / (1.f + __expf(-x)); }
DI float sigmoidf(float x) { return 1.f / (1.f + __expf(-x)); }
DI float softplusf(float x) { return x > 20.f ? x : log1pf(expf(x)); }
template <int CTRL> DI float dppf(float v) { return __int_as_float(__builtin_amdgcn_update_dpp(0, __float_as_int(v), CTRL, 0xf, 0xf, false)); }
DI float red4(float v) { v += dppf<0xB1>(v); v += dppf<0x4E>(v); return v; }
DI float red8(float v) { v = red4(v); v += dppf<0x141>(v); return v; }
DI float red16(float v) { v = red8(v); v += dppf<0x128>(v); return v; }
DI float wave_sum(float v) {
#pragma unroll
  for (int o = 32; o >= 1; o >>= 1) v += __shfl_xor(v, o);
  return v;
}
DI float* xrow(const Params& P, int g) {
  int b = g / TB, p = g - b * TB;
  return p < CL ? (float*)(WSP + OFF_XCTX) + ((size_t)(b * CL + p)) * D : XLATP + ((size_t)b * 8192 + (p - CL)) * D;
}
#define MFMA16(a, b, c) __builtin_amdgcn_mfma_f32_16x16x32_bf16((a), (b), (c), 0, 0, 0)

DI void phase_init(const Params& P, char* smem) {
  const int tid = ltid(), lane = tid & 63, wave = tid >> 6;
  float* sil = (float*)smem;
  float* red = sil + 5 * 1024;
  const float* c = IN(I_C);
  const float* cc = IN(I_CCTX);
  for (int i = tid; i < 5 * 1024; i += 256) {
    int r = i >> 10, k = i & 1023;
    float x = r < 4 ? c[r * 1024 + k] : cc[k];
    sil[i] = x / (1.f + expf(-x));
  }
  __syncthreads();
  float* mod = (float*)(WSP + OFF_MOD);
  for (int item = lbid(); item < 576; item += gridDim.x) {
    int l = item / 144, n = (item % 144) * 64 + lane;
    const float* w = IN(I_ADAW) + (size_t)l * 1024 * 9216 + n;
    float a0 = 0.f, a1 = 0.f, a2 = 0.f, a3 = 0.f, a4 = 0.f;
#pragma unroll 8
    for (int k = wave * 256; k < wave * 256 + 256; ++k) {
      float wv = w[(size_t)k * 9216];
      a0 += sil[k] * wv; a1 += sil[1024 + k] * wv; a2 += sil[2048 + k] * wv; a3 += sil[3072 + k] * wv; a4 += sil[4096 + k] * wv;
    }
    red[(wave * 5 + 0) * 64 + lane] = a0; red[(wave * 5 + 1) * 64 + lane] = a1; red[(wave * 5 + 2) * 64 + lane] = a2;
    red[(wave * 5 + 3) * 64 + lane] = a3; red[(wave * 5 + 4) * 64 + lane] = a4;
    __syncthreads();
    if (wave == 0) {
      float bias = IN(I_ADAB)[l * 9216 + n];
#pragma unroll
      for (int r = 0; r < 5; ++r) {
        float s = red[r * 64 + lane] + red[(5 + r) * 64 + lane] + red[(10 + r) * 64 + lane] + red[(15 + r) * 64 + lane] + bias;
        mod[((size_t)(l * 5 + r)) * 9216 + n] = s;
      }
    }
    __syncthreads();
  }
  if (lbid() == 0) {
    float* cosT = (float*)(WSP + OFF_ROPE);
    float* sinT = cosT + 2048;
    for (int i = tid; i < 2048; i += 256) {
      int pos = i >> 4, f = i & 15;
      float inv = powf(10000.f, -(float)f / 16.f);
      float ang = (float)pos * inv;
      cosT[i] = cosf(ang); sinT[i] = sinf(ang);
    }
  }
  const size_t gt = (size_t)lbid() * 256 + tid, gn = (size_t)gridDim.x * 256;
  const float4* xs = (const float4*)IN(I_X);
  float4* xd = (float4*)XLATP;
  for (size_t i = gt; i < (size_t)NB * 8192 * D / 4; i += gn) xd[i] = xs[i];
  const float4* cs = (const float4*)IN(I_CTX);
  float4* cd = (float4*)(WSP + OFF_XCTX);
  for (size_t i = gt; i < (size_t)NB * CL * D / 4; i += gn) cd[i] = cs[i];
}

DI void conv_job(const float* src, int ld, int K, int Nsrc, int Ndst, bf16* dst, int mapmode, int cbid, int cnb) {
  const size_t gt = (size_t)cbid * 256 + ltid(), gn = (size_t)cnb * 256;
  const size_t total = (size_t)Ndst * (K / 8);
  for (size_t id = gt; id < total; id += gn) {
    int n = (int)(id % Ndst), kc = (int)(id / Ndst);
    int col = n;
    if (mapmode == 1) { int j = 16 * (n >> 5) + (n & 15); col = ((n >> 4) & 1) ? FH + j : j; }
    bf16x8 o;
    if (n < Nsrc) {
      const float* s = src + (size_t)(kc * 8) * ld + col;
#pragma unroll
      for (int jj = 0; jj < 8; ++jj) o[jj] = (short)f2bf(s[(size_t)jj * ld]);
    } else {
#pragma unroll
      for (int jj = 0; jj < 8; ++jj) o[jj] = 0;
    }
    *(bf16x8*)(dst + (size_t)n * K + kc * 8) = o;
  }
}

DI void phase_convert(const Params& P, int l, int cbid, int cnb) {
  bf16* W = (bf16*)(WSP + OFF_W) + (size_t)(l & 1) * W_STRIDE;
  conv_job(IN(I_FWIN) + (size_t)(l * 2 + 0) * 1024 * 5632, 5632, 1024, 5632, 5632, W + W_FIN0, 1, cbid, cnb);
  conv_job(IN(I_FWOUT) + (size_t)(l * 2 + 0) * FH * 1024, 1024, FH, 1024, 1024, W + W_FOUT0, 0, cbid, cnb);
  conv_job(IN(I_FWIN) + (size_t)(l * 2 + 1) * 1024 * 5632, 5632, 1024, 5632, 5632, W + W_FIN1, 1, cbid, cnb);
  conv_job(IN(I_FWOUT) + (size_t)(l * 2 + 1) * FH * 1024, 1024, FH, 1024, 1024, W + W_FOUT1, 0, cbid, cnb);
  const int j = l >> 1;
  if ((l & 1) == 0) {
    conv_job(IN(I_EWIN) + (size_t)j * 1024 * 5664, 5664, 1024, 5664, 5888, W + W_EIN, 0, cbid, cnb);
    conv_job(IN(I_EWOUT) + (size_t)j * 2048 * 1024, 1024, 2048, 1024, 1024, W + W_EOUT, 0, cbid, cnb);
  } else {
    conv_job(IN(I_WR) + (size_t)j * 1048576, 1024, 1024, 1024, 1024, W + W_R, 0, cbid, cnb);
    conv_job(IN(I_WK) + (size_t)j * 1048576, 1024, 1024, 1024, 1024, W + W_K, 0, cbid, cnb);
    conv_job(IN(I_WV) + (size_t)j * 1048576, 1024, 1024, 1024, 1024, W + W_V, 0, cbid, cnb);
    conv_job(IN(I_WO) + (size_t)j * 1048576, 1024, 1024, 1024, 1024, W + W_O, 0, cbid, cnb);
    for (int e = 0; e < 2; ++e) {
      conv_job(IN(I_W1) + (size_t)(j * 2 + e) * 65536, 64, 1024, 64, 64, W + W_W1 + e * 65536, 0, cbid, cnb);
      conv_job(IN(I_A1) + (size_t)(j * 2 + e) * 65536, 64, 1024, 64, 64, W + W_A1 + e * 65536, 0, cbid, cnb);
    }
    conv_job(IN(I_G1) + (size_t)j * 163840, 160, 1024, 160, 160, W + W_G1, 0, cbid, cnb);
    conv_job(IN(I_G2) + (size_t)j * 163840, 1024, 160, 1024, 1024, W + W_G2, 0, cbid, cnb);
    if (j > 0) {
      conv_job(IN(I_V1) + (size_t)(j - 1) * 32768, 32, 1024, 32, 32, W + W_V1, 0, cbid, cnb);
      conv_job(IN(I_V2) + (size_t)(j - 1) * 32768, 1024, 32, 1024, 1024, W + W_V2, 0, cbid, cnb);
    }
  }
}

DI void phase_postpre(const Params& P, bool do_post, int lpost, int spost, float wgt, bool do_pre, int lpre, int spre) {
  const int lane = ltid() & 63;
  const int gw = lbid() * 4 + (ltid() >> 6), nw = gridDim.x * 4;
  const float* mod = (const float*)(WSP + OFF_MOD);
  const bf16* Y = (const bf16*)(WSP + OFF_Y);
  bf16* H = (bf16*)(WSP + OFF_H);
  for (int g = gw; g < M; g += nw) {
    const int b = g / TB, p = g - b * TB, r5 = p < CL ? 4 : b;
    float* x = xrow(P, g);
    float4 xq[4], gq[4], nq[4], shq[4], scq[4], npq[4];
    bf16x4 yq[4];
#pragma unroll
    for (int i = 0; i < 4; ++i) xq[i] = *(const float4*)(x + i * 256 + lane * 4);
    if (do_post) {
      const float* gate = mod + ((size_t)(lpost * 5 + r5) * 9 + 3 * spost + 2) * 1024;
      const float* nwp = IN(I_NORMW) + (size_t)(lpost * 6 + 2 * spost + 1) * 1024;
#pragma unroll
      for (int i = 0; i < 4; ++i) {
        yq[i] = *(const bf16x4*)(Y + (size_t)g * D + i * 256 + lane * 4);
        gq[i] = *(const float4*)(gate + i * 256 + lane * 4);
        nq[i] = *(const float4*)(nwp + i * 256 + lane * 4);
      }
    }
    if (do_pre) {
      const float* shift = mod + ((size_t)(lpre * 5 + r5) * 9 + 3 * spre) * 1024;
      const float* nwp = IN(I_NORMW) + (size_t)(lpre * 6 + 2 * spre) * 1024;
#pragma unroll
      for (int i = 0; i < 4; ++i) {
        shq[i] = *(const float4*)(shift + i * 256 + lane * 4);
        scq[i] = *(const float4*)(shift + 1024 + i * 256 + lane * 4);
        npq[i] = *(const float4*)(nwp + i * 256 + lane * 4);
      }
    }
    float xv[16];
#pragma unroll
    for (int i = 0; i < 4; ++i) { xv[4 * i] = xq[i].x; xv[4 * i + 1] = xq[i].y; xv[4 * i + 2] = xq[i].z; xv[4 * i + 3] = xq[i].w; }
    if (do_post) {
      float yv[16]; float ss = 0.f;
#pragma unroll
      for (int i = 0; i < 4; ++i)
#pragma unroll
        for (int e = 0; e < 4; ++e) { const float v = bf2f((bf16)yq[i][e]); yv[4 * i + e] = v; ss += v * v; }
      ss = wave_sum(ss);
      const float rs = rsqrtf(ss * (1.f / 1024.f) + 1e-6f);
#pragma unroll
      for (int i = 0; i < 4; ++i) {
        xv[4 * i] += wgt * gq[i].x * (yv[4 * i] * rs * nq[i].x);
        xv[4 * i + 1] += wgt * gq[i].y * (yv[4 * i + 1] * rs * nq[i].y);
        xv[4 * i + 2] += wgt * gq[i].z * (yv[4 * i + 2] * rs * nq[i].z);
        xv[4 * i + 3] += wgt * gq[i].w * (yv[4 * i + 3] * rs * nq[i].w);
      }
#pragma unroll
      for (int i = 0; i < 4; ++i) *(float4*)(x + i * 256 + lane * 4) = make_float4(xv[4 * i], xv[4 * i + 1], xv[4 * i + 2], xv[4 * i + 3]);
    }
    if (do_pre) {
      float ss = 0.f;
#pragma unroll
      for (int i = 0; i < 16; ++i) ss += xv[i] * xv[i];
      ss = wave_sum(ss);
      const float rs = rsqrtf(ss * (1.f / 1024.f) + 1e-6f);
#pragma unroll
      for (int i = 0; i < 4; ++i) {
        bf16x4 o;
        o[0] = (short)f2bf(xv[4 * i] * rs * npq[i].x * (1.f + scq[i].x) + shq[i].x);
        o[1] = (short)f2bf(xv[4 * i + 1] * rs * npq[i].y * (1.f + scq[i].y) + shq[i].y);
        o[2] = (short)f2bf(xv[4 * i + 2] * rs * npq[i].z * (1.f + scq[i].z) + shq[i].z);
        o[3] = (short)f2bf(xv[4 * i + 3] * rs * npq[i].w * (1.f + scq[i].w) + shq[i].w);
        *(bf16x4*)(H + (size_t)g * D + i * 256 + lane * 4) = o;
      }
    }
  }
}

struct GA {
  const bf16* A; const bf16* A2; int lda; int ksplit;
  const float* mu;
  const bf16* Wt; int K; int N;
  bf16* o0; bf16* o1; int ldc; int act;
  const float* f0;
};
enum { EPI_STORE = 0, EPI_SWIGLU = 1, EPI_EVENIN = 2, EPI_VMIX = 3, EPI_GMUL = 4 };

template <int EPI, int WN>
DI void gemm_epilogue(const Params& P, const GA& g, int m0, int n0, int wm, int wn, int l15, int Q, f32x4 (&acc)[4][WN]) {
  const int wc0 = n0 + wn * (16 * WN);
  if constexpr (EPI == EPI_STORE) {
#pragma unroll
    for (int mt = 0; mt < 4; ++mt) {
      const size_t row = m0 + wm * 64 + mt * 16 + l15;
#pragma unroll
      for (int nt = 0; nt < WN; ++nt) {
        const int col = wc0 + nt * 16 + 4 * Q;
        if (col < g.N) {
          bf16x4 o;
#pragma unroll
          for (int r = 0; r < 4; ++r) {
            float v = acc[mt][nt][r];
            if (g.act == 1) v = tanhf(v); else if (g.act == 2) v = sigmoidf(v);
            o[r] = (short)f2bf(v);
          }
          *(bf16x4*)(g.o0 + row * g.ldc + col) = o;
          if (g.o1) *(bf16x4*)(g.o1 + row * g.ldc + col) = o;
        }
      }
    }
  } else if constexpr (EPI == EPI_SWIGLU) {
#pragma unroll
    for (int mt = 0; mt < 4; ++mt) {
      const size_t row = m0 + wm * 64 + mt * 16 + l15;
#pragma unroll
      for (int pr = 0; pr < WN / 2; ++pr) {
        const int jcol = (wc0 >> 1) + pr * 16 + 4 * Q;
        bf16x4 o;
#pragma unroll
        for (int r = 0; r < 4; ++r) {
          const float gt = acc[mt][2 * pr][r];
          o[r] = (short)f2bf(gt * __builtin_amdgcn_rcpf(1.f + __expf(-gt)) * acc[mt][2 * pr + 1][r]);
        }
        *(bf16x4*)(g.o0 + row * FH + jcol) = o;
      }
    }
  } else if constexpr (EPI == EPI_EVENIN) {
    bf16* Qb = (bf16*)(WSP + OFF_BIG);
    bf16* Kb = Qb + (size_t)M * D;
    bf16* Vt = Kb + (size_t)M * D;
    bf16* Zb = Vt + (size_t)M * D;
    bf16* BCb = Zb + (size_t)M * D;
    bf16* XS = (bf16*)(WSP + OFF_Y);
    float* DT = (float*)(WSP + OFF_DT);
    if (n0 < 2048) {
      const bool isq = n0 < 1024;
      bf16* dst = isq ? Qb : Kb;
      const float sc = isq ? 0.125f * 1.4426950408889634f : 1.f;
      const float* cosT = (const float*)(WSP + OFF_ROPE);
      const float* sinT = cosT + 2048;
#pragma unroll
      for (int vs = 0; vs < WN / 4; ++vs) {
        const int cb = (isq ? wc0 : wc0 - 1024) + vs * 64 + l15;
#pragma unroll
        for (int mt = 0; mt < 4; ++mt)
#pragma unroll
          for (int r = 0; r < 4; ++r) {
            const int row = m0 + wm * 64 + mt * 16 + 4 * Q + r;
            const int p = row % TB;
            float x1 = acc[mt][4 * vs + 0][r], x2 = acc[mt][4 * vs + 1][r], x3 = acc[mt][4 * vs + 2][r], x4 = acc[mt][4 * vs + 3][r];
            if (p >= CL) {
              const int t = p - CL, pr = t >> 6, pc = t & 63;
              const float cr = cosT[pr * 16 + l15], sr = sinT[pr * 16 + l15], c2 = cosT[pc * 16 + l15], s2 = sinT[pc * 16 + l15];
              const float o1 = x1 * cr - x2 * sr, o2 = x2 * cr + x1 * sr, o3 = x3 * c2 - x4 * s2, o4 = x4 * c2 + x3 * s2;
              x1 = o1; x2 = o2; x3 = o3; x4 = o4;
            }
            bf16* d = dst + (size_t)row * D + cb;
            d[0] = f2bf(x1 * sc); d[16] = f2bf(x2 * sc); d[32] = f2bf(x3 * sc); d[48] = f2bf(x4 * sc);
          }
      }
    } else if (n0 < 3072) {
      const int b = m0 / TB, pb = m0 - b * TB;
#pragma unroll
      for (int mt = 0; mt < 4; ++mt)
#pragma unroll
        for (int nt = 0; nt < WN; ++nt) {
          const int c = wc0 - 2048 + nt * 16 + l15;
          const int p0 = pb + wm * 64 + mt * 16 + 4 * Q;
          bf16x4 o;
#pragma unroll
          for (int r = 0; r < 4; ++r) o[r] = (short)f2bf(acc[mt][nt][r]);
          *(bf16x4*)(Vt + ((size_t)(b * 1024 + c)) * TB + p0) = o;
        }
    } else if (n0 < 5632) {
      bf16* dst; int ld, cb;
      if (n0 < 4096) { dst = Zb; ld = 1024; cb = wc0 - 3072; }
      else if (n0 < 5120) { dst = XS; ld = 1024; cb = wc0 - 4096; }
      else { dst = BCb; ld = 512; cb = wc0 - 5120; }
#pragma unroll
      for (int mt = 0; mt < 4; ++mt)
#pragma unroll
        for (int nt = 0; nt < WN; ++nt)
#pragma unroll
          for (int r = 0; r < 4; ++r) {
            const size_t row = m0 + wm * 64 + mt * 16 + 4 * Q + r;
            dst[row * ld + cb + nt * 16 + l15] = f2bf(acc[mt][nt][r]);
          }
    } else {
#pragma unroll
      for (int mt = 0; mt < 4; ++mt)
#pragma unroll
        for (int nt = 0; nt < WN; ++nt) {
          const int col = wc0 - 5632 + nt * 16 + l15;
          if (col < 32) {
#pragma unroll
            for (int r = 0; r < 4; ++r) {
              const size_t row = m0 + wm * 64 + mt * 16 + 4 * Q + r;
              DT[row * 32 + col] = acc[mt][nt][r];
            }
          }
        }
    }
  } else if constexpr (EPI == EPI_VMIX) {
    const bf16* VF = (const bf16*)(WSP + OFF_VF);
#pragma unroll
    for (int mt = 0; mt < 4; ++mt) {
      const size_t rb = (size_t)(m0 + wm * 64 + mt * 16 + l15) * D + wc0 + 4 * Q;
      bf16x4 ov[WN], of[WN];
      float4 v0[WN];
#pragma unroll
      for (int nt = 0; nt < WN; ++nt) {
        ov[nt] = *(const bf16x4*)(g.o0 + rb + nt * 16);
        of[nt] = *(const bf16x4*)(VF + rb + nt * 16);
        v0[nt] = *(const float4*)(g.f0 + wc0 + nt * 16 + 4 * Q);
      }
#pragma unroll
      for (int nt = 0; nt < WN; ++nt) {
        const float vz[4] = {v0[nt].x, v0[nt].y, v0[nt].z, v0[nt].w};
        bf16x4 o;
#pragma unroll
        for (int r = 0; r < 4; ++r) {
          const float v = bf2f((bf16)ov[nt][r]), vf = bf2f((bf16)of[nt][r]);
          o[r] = (short)f2bf(v + (vf - v) * sigmoidf(vz[r] + acc[mt][nt][r]));
        }
        *(bf16x4*)(g.o0 + rb + nt * 16) = o;
      }
    }
  } else if constexpr (EPI == EPI_GMUL) {
#pragma unroll
    for (int mt = 0; mt < 4; ++mt) {
      const size_t rb = (size_t)(m0 + wm * 64 + mt * 16 + l15) * D + wc0 + 4 * Q;
      bf16x4 ov[WN];
#pragma unroll
      for (int nt = 0; nt < WN; ++nt) ov[nt] = *(const bf16x4*)(g.o0 + rb + nt * 16);
#pragma unroll
      for (int nt = 0; nt < WN; ++nt) {
        bf16x4 o;
#pragma unroll
        for (int r = 0; r < 4; ++r) o[r] = (short)f2bf(bf2f((bf16)ov[nt][r]) * acc[mt][nt][r]);
        *(bf16x4*)(g.o0 + rb + nt * 16) = o;
      }
    }
  }
}

template <int BK, int AMODE, int EPI, int WN>
DI void gemm_phase(const Params& P, const GA& g, char* smem) {
  constexpr int LS = BK;
  constexpr int CPR = BK / 8;
  constexpr int BN = 32 * WN;
  constexpr int NCHA = 128 * CPR / 256, NCHB = BN * CPR / 256;
  constexpr int RSTEP = 256 / CPR;
  constexpr int BUF = (128 + BN) * LS;
  constexpr int GW = 8;
#define SWZ(row, c) ((BK == 64) ? ((c) ^ (((row) >> 1) & 7)) : ((c) ^ ((4 - (((row) >> 2) & 3)) & 3)))
  bf16* S0 = (bf16*)smem;
  const int tid = ltid(), lane = tid & 63, wave = tid >> 6, wm = wave >> 1, wn = wave & 1, l15 = lane & 15, Q = lane >> 4;
  const int ntn = (g.N + BN - 1) / BN, ntiles = (M / 128) * ntn;
  const int nk = g.K / BK;
  const int crow = tid / CPR, ckc = tid - crow * CPR;
  int tile_first = lbid();
  if constexpr (AMODE == 1) {
    tile_first = (tile_first - g.ksplit) % (int)gridDim.x;
    if (tile_first < 0) tile_first += (int)gridDim.x;
  }
  for (int tile = tile_first; tile < ntiles; tile += gridDim.x) {
    int tmi, tni;
    {
      const int x = tile & 7, i = tile >> 3, nfull = ntn / GW, rem = ntn - nfull * GW;
      if (i < nfull * (33 * GW)) { const int g8 = i / (33 * GW), ii = i - g8 * (33 * GW); tni = g8 * GW + (ii % GW); tmi = x * 33 + ii / GW; }
      else { const int ii = i - nfull * (33 * GW); tni = nfull * GW + ii % rem; tmi = x * 33 + ii / rem; }
    }
    const int m0 = tmi * 128, n0 = tni * BN;
    f32x4 acc[4][WN];
#pragma unroll
    for (int i = 0; i < 4; ++i)
#pragma unroll
      for (int j = 0; j < WN; ++j) acc[i][j] = f32x4{0.f, 0.f, 0.f, 0.f};
    struct RS { bf16x8 ra[NCHA], rb[NCHB], rp[AMODE ? NCHA : 1], rn[AMODE ? NCHA : 1]; float muv[AMODE ? 8 : 1]; };
    RS s0, s1;
    auto load_tiles = [&](RS& s, int kt) {
      const int k = kt * BK + ckc * 8;
#pragma unroll
      for (int i = 0; i < NCHA; ++i) {
        const int row = crow + i * RSTEP;
        const size_t gi = (size_t)(m0 + row);
        if constexpr (AMODE == 0) {
          const bf16* src = (g.A2 != nullptr && k >= g.ksplit) ? g.A2 + gi * g.lda + (k - g.ksplit) : g.A + gi * g.lda + k;
          s.ra[i] = *(const bf16x8*)src;
        } else {
          const int p = (int)(gi % TB);
          const bool hp = (p != 0) && (p != CL), hn = (p != CL - 1) && (p != TB - 1);
          const bf16* src = g.A + gi * g.lda + k;
          s.ra[i] = *(const bf16x8*)src;
          s.rp[i] = hp ? *(const bf16x8*)(src - g.lda) : bf16x8{0, 0, 0, 0, 0, 0, 0, 0};
          s.rn[i] = hn ? *(const bf16x8*)(src + g.lda) : bf16x8{0, 0, 0, 0, 0, 0, 0, 0};
        }
      }
#pragma unroll
      for (int i = 0; i < NCHB; ++i) {
        const int n = n0 + crow + i * RSTEP;
        if (n < g.N) s.rb[i] = *(const bf16x8*)(g.Wt + (size_t)n * g.K + k);
        else s.rb[i] = bf16x8{0, 0, 0, 0, 0, 0, 0, 0};
      }
      if constexpr (AMODE == 1) {
        const float4 m0v = *(const float4*)(g.mu + k), m1v = *(const float4*)(g.mu + k + 4);
        s.muv[0] = m0v.x; s.muv[1] = m0v.y; s.muv[2] = m0v.z; s.muv[3] = m0v.w; s.muv[4] = m1v.x; s.muv[5] = m1v.y; s.muv[6] = m1v.z; s.muv[7] = m1v.w;
      }
    };
    auto store_tiles = [&](const RS& s, int buf) {
      bf16* As = S0 + buf * BUF;
      bf16* Bs = As + 128 * LS;
#pragma unroll
      for (int i = 0; i < NCHA; ++i) {
        const int row = crow + i * RSTEP;
        if constexpr (AMODE == 0) {
          *(bf16x8*)(As + row * LS + SWZ(row, ckc) * 8) = s.ra[i];
        } else {
          bf16x8 o;
#pragma unroll
          for (int e = 0; e < 8; ++e) {
            const float hv = bf2f((bf16)s.ra[i][e]);
            const float pv = bf2f((bf16)s.rp[i][e]), nv = bf2f((bf16)s.rn[i][e]);
            o[e] = (short)f2bf(hv + (0.5f * (pv + nv) - hv) * s.muv[e]);
          }
          *(bf16x8*)(As + row * LS + SWZ(row, ckc) * 8) = o;
        }
      }
#pragma unroll
      for (int i = 0; i < NCHB; ++i) *(bf16x8*)(Bs + (crow + i * RSTEP) * LS + SWZ(crow + i * RSTEP, ckc) * 8) = s.rb[i];
    };
    auto compute = [&](int buf) {
      __builtin_amdgcn_s_setprio(1);
      const bf16* As = S0 + buf * BUF;
      const bf16* Bs = As + 128 * LS;
#pragma unroll
      for (int ks = 0; ks < BK / 32; ++ks) {
        bf16x8 af[4], bfr[WN];
#pragma unroll
        for (int t = 0; t < 4; ++t) af[t] = *(const bf16x8*)(As + (wm * 64 + t * 16 + l15) * LS + SWZ(l15, ks * 4 + Q) * 8);
#pragma unroll
        for (int t = 0; t < WN; ++t) bfr[t] = *(const bf16x8*)(Bs + (wn * (16 * WN) + t * 16 + l15) * LS + SWZ(l15, ks * 4 + Q) * 8);
#pragma unroll
        for (int mt = 0; mt < 4; ++mt)
#pragma unroll
          for (int nt = 0; nt < WN; ++nt) {
            if constexpr (EPI != EPI_EVENIN) acc[mt][nt] = MFMA16(bfr[nt], af[mt], acc[mt][nt]);
            else acc[mt][nt] = MFMA16(af[mt], bfr[nt], acc[mt][nt]);
          }
      }
      __builtin_amdgcn_s_setprio(0);
    };
    __syncthreads();
    load_tiles(s0, 0);
    store_tiles(s0, 0);
    if constexpr (AMODE == 0 && WN == 4) {
      if (nk > 1) load_tiles(s0, 1);
      __syncthreads();
      for (int kt = 0; kt < nk; kt += 2) {
        if (kt + 2 < nk) load_tiles(s1, kt + 2);
        compute(0);
        if (kt + 1 < nk) store_tiles(s0, 1);
        __syncthreads();
        if (kt + 1 < nk) {
          if (kt + 3 < nk) load_tiles(s0, kt + 3);
          compute(1);
          if (kt + 2 < nk) store_tiles(s1, 0);
          __syncthreads();
        }
      }
    } else {
      __syncthreads();
      for (int kt = 0; kt < nk; ++kt) {
        if (kt + 1 < nk) load_tiles(s0, kt + 1);
        compute(kt & 1);
        if (kt + 1 < nk) store_tiles(s0, (kt + 1) & 1);
        __syncthreads();
      }
    }
    gemm_epilogue<EPI, WN>(P, g, m0, n0, wm, wn, l15, Q, acc);
  }
}

DI GA make_ga(const bf16* A, int lda, const bf16* Wt, int K, int N, bf16* o0, int ldc) {
  GA g; g.A = A; g.A2 = nullptr; g.lda = lda; g.ksplit = 0; g.mu = nullptr; g.Wt = Wt; g.K = K; g.N = N; g.o0 = o0; g.o1 = nullptr; g.ldc = ldc; g.act = 0; g.f0 = nullptr;
  return g;
}

DI void phase_attn(const Params& P, int j, int layer, char* smem, bool dry) {
  bf16* Qb = (bf16*)(WSP + OFF_BIG);
  const bf16* Kb = Qb + (size_t)M * D;
  const bf16* Vt = Kb + (size_t)M * D;
  constexpr int KBYTES = 64 * 272, VBYTES = 128 * 144, STAGE = KBYTES + VBYTES;
  const int tid = ltid(), lane = tid & 63, wave = tid >> 6, l15 = lane & 15, Q = lane >> 4;
  const float lam_init = 0.8f - 0.6f * expf(-0.3f * (float)layer);
  float lam;
  {
    const float* lp = IN(I_LAMBDA) + j * 256;
    float s1 = 0.f, s2 = 0.f;
    for (int i = 0; i < 64; ++i) { s1 += lp[i] * lp[64 + i]; s2 += lp[128 + i] * lp[192 + i]; }
    lam = expf(s1) - expf(s2) + lam_init;
  }
  const float* subln = IN(I_SUBLN) + j * 128;
  const int nitems = 2048 + 64;
  const int krow = tid >> 4, kc16 = tid & 15, vrow = tid >> 3, vc = tid & 7;
  for (int item = lbid(); item < nitems; item += gridDim.x) {
    int b, h, q0, nkv;
    if (item < 2048) {
      const int x = item & 7, i = item >> 3, pair = x * 4 + (i >> 6);
      b = pair >> 3; h = pair & 7; q0 = CL + (i & 63) * 128; nkv = 132;
    } else { const int it = item - 2048; b = it >> 4; h = (it >> 1) & 7; q0 = (it & 1) * 128; nkv = 4; }
    const size_t gb = (size_t)b * TB;
    const bf16* Kbase = Kb + gb * D + h * 128 + kc16 * 8;
    const bf16* Vbase = Vt + ((size_t)(b * 1024 + h * 128)) * TB + vc * 8;
    bf16x8 Qf[2][2][2];
#pragma unroll
    for (int qt = 0; qt < 2; ++qt)
#pragma unroll
      for (int m = 0; m < 2; ++m)
#pragma unroll
        for (int ks = 0; ks < 2; ++ks)
          Qf[qt][m][ks] = *(const bf16x8*)(Qb + (gb + q0 + wave * 32 + qt * 16 + l15) * D + h * 128 + m * 64 + ks * 32 + Q * 8);
    float mrun[2][2], lrun[2][2];
#pragma unroll
    for (int qt = 0; qt < 2; ++qt)
#pragma unroll
      for (int m = 0; m < 2; ++m) { mrun[qt][m] = 0.f; lrun[qt][m] = 0.f; }
    bf16x8 pk[4], pv[4];
    __syncthreads();
#pragma unroll
    for (int i = 0; i < 4; ++i) pk[i] = *(const bf16x8*)(Kbase + (size_t)(krow + 16 * i) * D);
#pragma unroll
    for (int i = 0; i < 4; ++i) *(bf16x8*)(smem + (krow + 16 * i) * 272 + kc16 * 16) = pk[i];
    __syncthreads();
#pragma unroll
    for (int m = 0; m < 2; ++m) {
      float mx0 = -3.0e38f, mx1 = -3.0e38f;
#pragma unroll
      for (int kt = 0; kt < 4; ++kt) {
        const bf16x8 k0 = *(const bf16x8*)(smem + (kt * 16 + l15) * 272 + (m * 64 + Q * 8) * 2);
        const bf16x8 k1 = *(const bf16x8*)(smem + (kt * 16 + l15) * 272 + (m * 64 + 32 + Q * 8) * 2);
        f32x4 t0 = f32x4{0.f, 0.f, 0.f, 0.f}, t1 = f32x4{0.f, 0.f, 0.f, 0.f};
        t0 = MFMA16(k0, Qf[0][m][0], t0); t0 = MFMA16(k1, Qf[0][m][1], t0);
        t1 = MFMA16(k0, Qf[1][m][0], t1); t1 = MFMA16(k1, Qf[1][m][1], t1);
        mx0 = fmaxf(fmaxf(mx0, fmaxf(t0[0], t0[1])), fmaxf(t0[2], t0[3]));
        mx1 = fmaxf(fmaxf(mx1, fmaxf(t1[0], t1[1])), fmaxf(t1[2], t1[3]));
      }
      mrun[0][m] = mx0 + 32.f; mrun[1][m] = mx1 + 32.f;
    }
    for (int kv = 0; kv < nkv; ++kv) {
      if (kv + 1 < nkv) {
#pragma unroll
        for (int i = 0; i < 4; ++i) pk[i] = *(const bf16x8*)(Kbase + (size_t)((kv + 1) * 64 + krow + 16 * i) * D);
      }
      const char* sK = smem + (kv & 1) * STAGE;
#pragma unroll
      for (int m = 0; m < 2; ++m) {
#pragma unroll
        for (int kt = 0; kt < 4; ++kt) {
          const bf16x8 k0 = *(const bf16x8*)(sK + (kt * 16 + l15) * 272 + (m * 64 + Q * 8) * 2);
          const bf16x8 k1 = *(const bf16x8*)(sK + (kt * 16 + l15) * 272 + (m * 64 + 32 + Q * 8) * 2);
#pragma unroll
          for (int qt = 0; qt < 2; ++qt) {
            const float nb = -mrun[qt][m];
            f32x4 t = f32x4{nb, nb, nb, nb};
            t = MFMA16(k0, Qf[qt][m][0], t);
            t = MFMA16(k1, Qf[qt][m][1], t);
            lrun[qt][m] += (__builtin_amdgcn_exp2f(t[0]) + __builtin_amdgcn_exp2f(t[1])) + (__builtin_amdgcn_exp2f(t[2]) + __builtin_amdgcn_exp2f(t[3]));
          }
        }
      }
      if (kv + 1 < nkv) {
        char* dK = smem + ((kv + 1) & 1) * STAGE;
#pragma unroll
        for (int i = 0; i < 4; ++i) *(bf16x8*)(dK + (krow + 16 * i) * 272 + kc16 * 16) = pk[i];
      }
      __syncthreads();
    }
    float Mx[2][2];
#pragma unroll
    for (int qt = 0; qt < 2; ++qt)
#pragma unroll
      for (int m = 0; m < 2; ++m) {
        float mm = mrun[qt][m], ll = lrun[qt][m];
#pragma unroll
        for (int o = 16; o <= 32; o <<= 1) {
          const float mo = __shfl_xor(mm, o), lo = __shfl_xor(ll, o);
          const float mn = fmaxf(mm, mo);
          ll = ll * __builtin_amdgcn_exp2f(mm - mn) + lo * __builtin_amdgcn_exp2f(mo - mn);
          mm = mn;
        }
        Mx[qt][m] = mm + __log2f(ll);
      }
    f32x4 O[2][8];
#pragma unroll
    for (int qt = 0; qt < 2; ++qt)
#pragma unroll
      for (int t = 0; t < 8; ++t) O[qt][t] = f32x4{0.f, 0.f, 0.f, 0.f};
#pragma unroll
    for (int i = 0; i < 4; ++i) {
      pk[i] = *(const bf16x8*)(Kbase + (size_t)(krow + 16 * i) * D);
      pv[i] = *(const bf16x8*)(Vbase + (size_t)(vrow + 32 * i) * TB);
    }
#pragma unroll
    for (int i = 0; i < 4; ++i) {
      *(bf16x8*)(smem + (krow + 16 * i) * 272 + kc16 * 16) = pk[i];
      *(bf16x8*)(smem + KBYTES + (vrow + 32 * i) * 144 + vc * 16) = pv[i];
    }
    __syncthreads();
    for (int kv = 0; kv < nkv; ++kv) {
      if (kv + 1 < nkv) {
#pragma unroll
        for (int i = 0; i < 4; ++i) {
          pk[i] = *(const bf16x8*)(Kbase + (size_t)((kv + 1) * 64 + krow + 16 * i) * D);
          pv[i] = *(const bf16x8*)(Vbase + (size_t)(vrow + 32 * i) * TB + (kv + 1) * 64);
        }
      }
      const char* sK = smem + (kv & 1) * STAGE;
      const char* sV = sK + KBYTES;
#pragma unroll
      for (int ks2 = 0; ks2 < 2; ++ks2) {
        bf16x8 Pf[2];
#pragma unroll
        for (int half = 0; half < 2; ++half) {
          const int kt = ks2 * 2 + half;
          f32x4 s[2][2];
#pragma unroll
          for (int m = 0; m < 2; ++m) {
            const bf16x8 k0 = *(const bf16x8*)(sK + (kt * 16 + l15) * 272 + (m * 64 + Q * 8) * 2);
            const bf16x8 k1 = *(const bf16x8*)(sK + (kt * 16 + l15) * 272 + (m * 64 + 32 + Q * 8) * 2);
#pragma unroll
            for (int qt = 0; qt < 2; ++qt) {
              const float nm = -Mx[qt][m];
              f32x4 t = f32x4{nm, nm, nm, nm};
              t = MFMA16(k0, Qf[qt][m][0], t);
              t = MFMA16(k1, Qf[qt][m][1], t);
              s[qt][m] = t;
            }
          }
#pragma unroll
          for (int qt = 0; qt < 2; ++qt)
#pragma unroll
            for (int r = 0; r < 4; ++r) {
              const float a = __builtin_amdgcn_exp2f(s[qt][0][r]) - lam * __builtin_amdgcn_exp2f(s[qt][1][r]);
              Pf[qt][half * 4 + r] = (short)f2bf(a);
            }
        }
        __builtin_amdgcn_s_setprio(1);
#pragma unroll
        for (int t = 0; t < 8; ++t) {
          const bf16x4 v0 = *(const bf16x4*)(sV + (t * 16 + l15) * 144 + (ks2 * 32 + Q * 4) * 2);
          const bf16x4 v1 = *(const bf16x4*)(sV + (t * 16 + l15) * 144 + (ks2 * 32 + 16 + Q * 4) * 2);
          const bf16x8 vf = __builtin_shufflevector(v0, v1, 0, 1, 2, 3, 4, 5, 6, 7);
#pragma unroll
          for (int qt = 0; qt < 2; ++qt) O[qt][t] = MFMA16(vf, Pf[qt], O[qt][t]);
        }
        __builtin_amdgcn_s_setprio(0);
      }
      if (kv + 1 < nkv) {
        char* dK = smem + ((kv + 1) & 1) * STAGE;
#pragma unroll
        for (int i = 0; i < 4; ++i) {
          *(bf16x8*)(dK + (krow + 16 * i) * 272 + kc16 * 16) = pk[i];
          *(bf16x8*)(dK + KBYTES + (vrow + 32 * i) * 144 + vc * 16) = pv[i];
        }
      }
      __syncthreads();
    }
    if (!dry) {
      float4 swv[8];
#pragma unroll
      for (int t = 0; t < 8; ++t) swv[t] = *(const float4*)(subln + t * 16 + Q * 4);
#pragma unroll
      for (int qt = 0; qt < 2; ++qt) {
        float ss = 0.f;
#pragma unroll
        for (int t = 0; t < 8; ++t)
#pragma unroll
          for (int r = 0; r < 4; ++r) ss += O[qt][t][r] * O[qt][t][r];
        ss += __shfl_xor(ss, 16);
        ss += __shfl_xor(ss, 32);
        const float rs = rsqrtf(ss * (1.f / 128.f) + 1e-5f) * (1.f - lam_init);
        bf16* dst = Qb + (gb + q0 + wave * 32 + qt * 16 + l15) * D + h * 128;
#pragma unroll
        for (int t = 0; t < 8; ++t) {
          const float4 sw = swv[t];
          bf16x4 o;
          o[0] = (short)f2bf(O[qt][t][0] * rs * sw.x); o[1] = (short)f2bf(O[qt][t][1] * rs * sw.y);
          o[2] = (short)f2bf(O[qt][t][2] * rs * sw.z); o[3] = (short)f2bf(O[qt][t][3] * rs * sw.w);
          *(bf16x4*)(dst + t * 16 + Q * 4) = o;
        }
      }
    }
  }
}

DI void phase_ssd_scan(const Params& P, int j, char* smem, int cu_idx, int nact) {
  float* sX = (float*)smem;
  float* sB = sX + 32 * 64;
  float* sC = sB + 32 * 128;
  float* sDt = sC + 32 * 128;
  float* sDA = sDt + 32;
  float* sY = sDA + 32;
  bf16* sRaw = (bf16*)(sY + 1024);
  const bf16* XS = (const bf16*)(WSP + OFF_Y);
  const bf16* BCb = (const bf16*)(WSP + OFF_BIG) + (size_t)4 * M * D;
  const float* DT = (const float*)(WSP + OFF_DT);
  bf16* Y0 = (bf16*)(WSP + OFF_H);
  bf16* Y1 = (bf16*)(WSP + OFF_BIG) + (size_t)M * D;
  const int tid = ltid(), prow = tid >> 3, nq = tid & 7;
  if (cu_idx < 0) return;
  for (int item = cu_idx; item < 256; item += nact) {
    const int chain = item >> 1, sp = item & 1;
    const int b = chain >> 5, dir = (chain >> 4) & 1, head = chain & 15, grp = head >> 3;
    const size_t gb = (size_t)b * TB;
    const float a_h = -expf(IN(I_ALOG)[(j * 2 + dir) * 16 + head]);
    const float dbias = IN(I_DTBIAS)[(j * 2 + dir) * 16 + head];
    const float dskip = dir == 0 ? IN(I_SSDD)[j * 16 + head] : 0.f;
    bf16* Yd = dir == 0 ? Y0 : Y1;
    const int myp = sp * 32 + prow;
    const int step = dir == 0 ? 1 : -1;
    float hst[16];
#pragma unroll
    for (int e = 0; e < 16; ++e) hst[e] = 0.f;
    bf16x8 pre[6];
    float predt = 0.f;
    auto issue = [&](int s0n) {
      const bool isctx = s0n < CL;
      const int pfirst = dir == 0 ? s0n : (isctx ? 255 - s0n : 8703 - s0n);
      const int seg_lo = isctx ? 0 : CL, seg_hi = isctx ? CL : TB;
      const int plo = dir == 0 ? pfirst : pfirst - 31;
#pragma unroll
      for (int r = 0; r < 6; ++r) {
        const int id = tid + 256 * r;
        pre[r] = bf16x8{0, 0, 0, 0, 0, 0, 0, 0};
        if (id < 1440) {
          const int rr = id / 40, cc = id - rr * 40;
          const int q = plo - 2 + rr;
          if (q >= seg_lo && q < seg_hi) {
            const bf16* src = cc < 8 ? XS + (gb + q) * 1024 + head * 64 + cc * 8
                                     : (cc < 24 ? BCb + (gb + q) * 512 + grp * 128 + (cc - 8) * 8 : BCb + (gb + q) * 512 + 256 + grp * 128 + (cc - 24) * 8);
            pre[r] = *(const bf16x8*)src;
          }
        }
      }
      if (tid < 32) predt = DT[(gb + pfirst + tid * step) * 32 + dir * 16 + head];
    };
    issue(0);
    for (int s0 = 0; s0 < TB; s0 += 32) {
      const bool isctx = s0 < CL;
      const int pfirst = dir == 0 ? s0 : (isctx ? 255 - s0 : 8703 - s0);
#pragma unroll
      for (int r = 0; r < 6; ++r) {
        const int id = tid + 256 * r;
        if (id < 1440) { const int rr = id / 40, cc = id - rr * 40; *(bf16x8*)(sRaw + rr * 328 + cc * 8) = pre[r]; }
      }
      if (tid < 32) { const float dt = softplusf(predt + dbias); sDt[tid] = dt; sDA[tid] = __expf(dt * a_h); }
      __syncthreads();
      if (s0 + 32 < TB) issue(s0 + 32);
      for (int u = tid; u < 640; u += 256) {
        const int c = u % 320, hf = u / 320;
        int ch; float* dstp; int dld;
        if (c < 64) { ch = head * 64 + c; dstp = sX + c; dld = 64; }
        else if (c < 192) { const int n = c - 64; ch = 1024 + grp * 128 + n; dstp = sB + n; dld = 128; }
        else { const int n = c - 192; ch = 1280 + grp * 128 + n; dstp = sC + n; dld = 128; }
        float raw[20];
#pragma unroll
        for (int i = 0; i < 20; ++i) raw[i] = bf2f(sRaw[(hf * 16 + i) * 328 + c]);
        const float* cw = IN(I_CONVW) + (size_t)j * 5 * 1536 + ch;
        const float w0 = cw[0], w1 = cw[1536], w2 = cw[2 * 1536], w3 = cw[3 * 1536], w4 = cw[4 * 1536];
        const float cbias = IN(I_CONVB)[j * 1536 + ch];
#pragma unroll
        for (int ii = 0; ii < 16; ++ii) {
          float v = cbias + w0 * raw[ii] + w1 * raw[ii + 1] + w2 * raw[ii + 2] + w3 * raw[ii + 3] + w4 * raw[ii + 4];
          v = v * __builtin_amdgcn_rcpf(1.f + __expf(-v));
          const int nl = hf * 16 + ii;
          const int li = dir == 0 ? nl : 31 - nl;
          dstp[li * dld] = v;
        }
      }
      __syncthreads();
      float4 bq[4], cq[4];
#pragma unroll
      for (int e = 0; e < 4; ++e) { bq[e] = *(const float4*)(sB + nq * 16 + e * 4); cq[e] = *(const float4*)(sC + nq * 16 + e * 4); }
      float xv = sX[myp], dt = sDt[0], dA = sDA[0];
#pragma unroll 2
      for (int i = 0; i < 32; ++i) {
        const int in = i < 31 ? i + 1 : 31;
        float4 nb[4], nc[4];
#pragma unroll
        for (int e = 0; e < 4; ++e) { nb[e] = *(const float4*)(sB + in * 128 + nq * 16 + e * 4); nc[e] = *(const float4*)(sC + in * 128 + nq * 16 + e * 4); }
        const float nxv = sX[in * 64 + myp], ndt = sDt[in], ndA = sDA[in];
        const float xdt = xv * dt;
        float pp[4];
#pragma unroll
        for (int e = 0; e < 4; ++e) {
          hst[4 * e + 0] = dA * hst[4 * e + 0] + xdt * bq[e].x; hst[4 * e + 1] = dA * hst[4 * e + 1] + xdt * bq[e].y;
          hst[4 * e + 2] = dA * hst[4 * e + 2] + xdt * bq[e].z; hst[4 * e + 3] = dA * hst[4 * e + 3] + xdt * bq[e].w;
          pp[e] = (cq[e].x * hst[4 * e + 0] + cq[e].y * hst[4 * e + 1]) + (cq[e].z * hst[4 * e + 2] + cq[e].w * hst[4 * e + 3]);
        }
        float part = (pp[0] + pp[1]) + (pp[2] + pp[3]);
        part = red8(part);
        if (nq == 0) sY[i * 32 + prow] = part + dskip * xv;
#pragma unroll
        for (int e = 0; e < 4; ++e) { bq[e] = nb[e]; cq[e] = nc[e]; }
        xv = nxv; dt = ndt; dA = ndA;
      }
      __syncthreads();
      {
        const int i = tid >> 3, r4 = (tid & 7) * 4;
        const int p = pfirst + i * step;
        bf16x4 o;
        o[0] = (short)f2bf(sY[i * 32 + r4]); o[1] = (short)f2bf(sY[i * 32 + r4 + 1]); o[2] = (short)f2bf(sY[i * 32 + r4 + 2]); o[3] = (short)f2bf(sY[i * 32 + r4 + 3]);
        *(bf16x4*)(Yd + (gb + p) * D + head * 64 + sp * 32 + r4) = o;
      }
    }
    __syncthreads();
  }
}

DI void phase_bcconv(const Params& P, int j) {
  const int lane = ltid() & 63;
  const int gw = lbid() * 4 + (ltid() >> 6), nw = gridDim.x * 4;
  const bf16* BCb = (const bf16*)(WSP + OFF_BIG) + (size_t)4 * M * D;
  bf16* BCc = (bf16*)(WSP + OFF_BIG) + (size_t)2 * M * D;
  const float* cw = IN(I_CONVW) + (size_t)j * 5 * 1536 + 1024 + lane * 8;
  const float* cb = IN(I_CONVB) + j * 1536 + 1024 + lane * 8;
  float w[5][8], bias[8];
#pragma unroll
  for (int t = 0; t < 5; ++t)
#pragma unroll
    for (int e = 0; e < 8; ++e) w[t][e] = cw[t * 1536 + e];
#pragma unroll
  for (int e = 0; e < 8; ++e) bias[e] = cb[e];
  for (int run = gw; run < M / 16; run += nw) {
    const int g0 = run * 16, b = g0 / TB, p0 = g0 - b * TB;
    const int seg_lo = p0 < CL ? 0 : CL, seg_hi = p0 < CL ? CL : TB;
    bf16x8 win[5];
#pragma unroll
    for (int t = 0; t < 4; ++t) {
      const int q = p0 - 2 + t;
      win[t + 1] = (q >= seg_lo && q < seg_hi) ? *(const bf16x8*)(BCb + ((size_t)b * TB + q) * 512 + lane * 8) : bf16x8{0, 0, 0, 0, 0, 0, 0, 0};
    }
#pragma unroll 4
    for (int i = 0; i < 16; ++i) {
#pragma unroll
      for (int t = 0; t < 4; ++t) win[t] = win[t + 1];
      const int q = p0 + i + 2;
      win[4] = (q < seg_hi) ? *(const bf16x8*)(BCb + ((size_t)b * TB + q) * 512 + lane * 8) : bf16x8{0, 0, 0, 0, 0, 0, 0, 0};
      bf16x8 o;
#pragma unroll
      for (int e = 0; e < 8; ++e) {
        float v = bias[e];
#pragma unroll
        for (int t = 0; t < 5; ++t) v += w[t][e] * bf2f((bf16)win[t][e]);
        v = v * __builtin_amdgcn_rcpf(1.f + __expf(-v));
        o[e] = (short)f2bf(v);
      }
      *(bf16x8*)(BCc + ((size_t)g0 + i) * 512 + lane * 8) = o;
    }
  }
}

DI void phase_ssd_chunk(const Params& P, int j, char* smem, int cu_idx, int nact) {
  bf16* sB = (bf16*)smem;
  bf16* sC = sB + 32 * 136;
  bf16* sBt = sC + 32 * 136;
  bf16* sXd = sBt + 128 * 40;
  bf16* sGm = sXd + 64 * 40;
  bf16* sH = sGm + 32 * 40;
  bf16* sXr = sH + 64 * 136;
  float* sDt = (float*)(sXr + 36 * 72);
  float* sAcs = sDt + 32;
  float* sScl = sAcs + 32;
  const bf16* XS = (const bf16*)(WSP + OFF_Y);
  const bf16* BCc = (const bf16*)(WSP + OFF_BIG) + (size_t)2 * M * D;
  const float* DT = (const float*)(WSP + OFF_DT);
  bf16* Y0 = (bf16*)(WSP + OFF_H);
  bf16* Y1 = (bf16*)(WSP + OFF_BIG) + (size_t)M * D;
  const int tid = ltid(), lane = tid & 63, wave = tid >> 6, l15 = lane & 15, Q = lane >> 4;
  if (cu_idx < 0) return;
  for (int item = cu_idx; item < 128; item += nact) {
    const int b = item >> 5, dir = (item >> 4) & 1, head = item & 15, grp = head >> 3;
    const size_t gb = (size_t)b * TB;
    const float a_h = -expf(IN(I_ALOG)[(j * 2 + dir) * 16 + head]);
    const float dbias = IN(I_DTBIAS)[(j * 2 + dir) * 16 + head];
    const float dskip = dir == 0 ? IN(I_SSDD)[j * 16 + head] : 0.f;
    bf16* Yd = dir == 0 ? Y0 : Y1;
    const int step = dir == 0 ? 1 : -1;
    const int cch = tid & 63, cq = tid >> 6;
    const float* cwp = IN(I_CONVW) + (size_t)j * 5 * 1536 + head * 64 + cch;
    const float w0 = cwp[0], w1 = cwp[1536], w2 = cwp[2 * 1536], w3 = cwp[3 * 1536], w4 = cwp[4 * 1536];
    const float cbias = IN(I_CONVB)[j * 1536 + head * 64 + cch];
    __syncthreads();
    for (int i = tid; i < 64 * 136 / 8; i += 256) *(bf16x8*)(sH + i * 8) = bf16x8{0, 0, 0, 0, 0, 0, 0, 0};
    f32x4 hacc[8];
#pragma unroll
    for (int t = 0; t < 8; ++t) hacc[t] = f32x4{0.f, 0.f, 0.f, 0.f};
    struct PF { bf16x8 px[2], pbc[4]; float predt; };
    PF pfa, pfb;
    pfa.predt = 0.f; pfb.predt = 0.f;
    auto issue = [&](PF& pf, int s0n) {
      const bool isctx = s0n < CL;
      const int pfirst = dir == 0 ? s0n : (isctx ? 255 - s0n : 8703 - s0n);
      const int seg_lo = isctx ? 0 : CL, seg_hi = isctx ? CL : TB;
      const int plo = dir == 0 ? pfirst : pfirst - 31;
#pragma unroll
      for (int r = 0; r < 2; ++r) {
        const int id = tid + 256 * r;
        pf.px[r] = bf16x8{0, 0, 0, 0, 0, 0, 0, 0};
        if (id < 288) {
          const int rr = id >> 3, cc = id & 7, q = plo - 2 + rr;
          if (q >= seg_lo && q < seg_hi) pf.px[r] = *(const bf16x8*)(XS + (gb + q) * 1024 + head * 64 + cc * 8);
        }
      }
#pragma unroll
      for (int r = 0; r < 4; ++r) {
        const int id = tid + 256 * r, li = id >> 5, cc = id & 31;
        const size_t gi = gb + pfirst + li * step;
        pf.pbc[r] = *(const bf16x8*)(BCc + gi * 512 + (cc < 16 ? grp * 128 + cc * 8 : 256 + grp * 128 + (cc - 16) * 8));
      }
      if (tid < 32) pf.predt = DT[(gb + pfirst + tid * step) * 32 + dir * 16 + head];
    };
    issue(pfa, 0);
    issue(pfb, 32);
    auto chunk = [&](int s0, PF& pf) {
      const bool isctx = s0 < CL;
      const int pfirst = dir == 0 ? s0 : (isctx ? 255 - s0 : 8703 - s0);
#pragma unroll
      for (int r = 0; r < 2; ++r) {
        const int id = tid + 256 * r;
        if (id < 288) *(bf16x8*)(sXr + (id >> 3) * 72 + (id & 7) * 8) = pf.px[r];
      }
#pragma unroll
      for (int r = 0; r < 4; ++r) {
        const int id = tid + 256 * r, li = id >> 5, cc = id & 31;
        if (cc < 16) *(bf16x8*)(sB + li * 136 + cc * 8) = pf.pbc[r];
        else *(bf16x8*)(sC + li * 136 + (cc - 16) * 8) = pf.pbc[r];
      }
      if (wave == 0) {
        const float xx = pf.predt + dbias, ex = __expf(xx);
        const float dt = xx > 20.f ? xx : (ex < 0.01f ? ex * (1.f - ex * (0.5f - ex * 0.33333334f)) : __logf(1.f + ex));
        float v = dt * a_h;
        v += __int_as_float(__builtin_amdgcn_update_dpp(0, __float_as_int(v), 0x111, 0xf, 0xf, true));
        v += __int_as_float(__builtin_amdgcn_update_dpp(0, __float_as_int(v), 0x112, 0xf, 0xf, true));
        v += __int_as_float(__builtin_amdgcn_update_dpp(0, __float_as_int(v), 0x114, 0xf, 0xf, true));
        v += __int_as_float(__builtin_amdgcn_update_dpp(0, __float_as_int(v), 0x118, 0xf, 0xf, true));
        const float r0 = __int_as_float(__builtin_amdgcn_readlane(__float_as_int(v), 15));
        if (lane >= 16) v += r0;
        const float lastv = __int_as_float(__builtin_amdgcn_readlane(__float_as_int(v), 31));
        if (lane < 32) { sDt[lane] = dt; sAcs[lane] = v; sScl[lane] = __expf(lastv - v); }
      }
      __syncthreads();
      if (s0 + 64 < TB) issue(pf, s0 + 64);
      const float acs_last = sAcs[31];
      {
        float raw[12];
#pragma unroll
        for (int i = 0; i < 12; ++i) raw[i] = bf2f(sXr[(cq * 8 + i) * 72 + cch]);
#pragma unroll
        for (int ii = 0; ii < 8; ++ii) {
          float v = cbias + w0 * raw[ii] + w1 * raw[ii + 1] + w2 * raw[ii + 2] + w3 * raw[ii + 3] + w4 * raw[ii + 4];
          v = v * __builtin_amdgcn_rcpf(1.f + __expf(-v));
          const int nl = cq * 8 + ii, li = dir == 0 ? nl : 31 - nl;
          sXd[cch * 40 + li] = f2bf(v * sDt[li]);
        }
#pragma unroll
        for (int e = 0; e < 2; ++e) {
          const int idx = tid + 256 * e, li = idx & 31, n8 = idx >> 5;
          const bf16x8 bv = *(const bf16x8*)(sB + li * 136 + n8 * 8);
          const float sc = sScl[li];
#pragma unroll
          for (int k = 0; k < 8; ++k) sBt[(n8 * 8 + k) * 40 + li] = f2bf(bf2f((bf16)bv[k]) * sc);
        }
      }
      {
        const int jt = wave >> 1, it = wave & 1;
        f32x4 acc = f32x4{0.f, 0.f, 0.f, 0.f};
        if (jt <= it) {
#pragma unroll
          for (int ks = 0; ks < 4; ++ks)
            acc = MFMA16(*(const bf16x8*)(sB + (16 * jt + l15) * 136 + 32 * ks + 8 * Q), *(const bf16x8*)(sC + (16 * it + l15) * 136 + 32 * ks + 8 * Q), acc);
        }
        const int i = 16 * it + l15;
        const float ai = sAcs[i];
        bf16x4 o;
#pragma unroll
        for (int r = 0; r < 4; ++r) {
          const int jx = 16 * jt + 4 * Q + r;
          float gv = (jx <= i) ? acc[r] * __expf(ai - sAcs[jx]) : 0.f;
          if (jx == i) gv += dskip / sDt[i];
          o[r] = (short)f2bf(gv);
        }
        *(bf16x4*)(sGm + i * 40 + 16 * jt + 4 * Q) = o;
      }
      __syncthreads();
      {
        const bf16x8 ax = *(const bf16x8*)(sXd + (16 * wave + l15) * 40 + 8 * Q);
#pragma unroll
        for (int it = 0; it < 2; ++it) {
          f32x4 accd = f32x4{0.f, 0.f, 0.f, 0.f}, acco = f32x4{0.f, 0.f, 0.f, 0.f};
          accd = MFMA16(ax, *(const bf16x8*)(sGm + (16 * it + l15) * 40 + 8 * Q), accd);
#pragma unroll
          for (int ks = 0; ks < 4; ++ks)
            acco = MFMA16(*(const bf16x8*)(sH + (16 * wave + l15) * 136 + 32 * ks + 8 * Q), *(const bf16x8*)(sC + (16 * it + l15) * 136 + 32 * ks + 8 * Q), acco);
          const int i = 16 * it + l15;
          const float ev = __expf(sAcs[i]);
          bf16x4 o;
#pragma unroll
          for (int r = 0; r < 4; ++r) o[r] = (short)f2bf(accd[r] + ev * acco[r]);
          *(bf16x4*)(Yd + (gb + pfirst + i * step) * D + head * 64 + 16 * wave + 4 * Q) = o;
        }
        const float dec = __expf(acs_last);
#pragma unroll
        for (int nt = 0; nt < 8; ++nt) {
          hacc[nt] = hacc[nt] * dec;
          hacc[nt] = MFMA16(*(const bf16x8*)(sBt + (16 * nt + l15) * 40 + 8 * Q), ax, hacc[nt]);
        }
      }
      __syncthreads();
#pragma unroll
      for (int nt = 0; nt < 8; ++nt) {
        bf16x4 o;
#pragma unroll
        for (int r = 0; r < 4; ++r) o[r] = (short)f2bf(hacc[nt][r]);
        *(bf16x4*)(sH + (16 * wave + l15) * 136 + 16 * nt + 4 * Q) = o;
      }
    };
    for (int s0 = 0; s0 < TB; s0 += 64) {
      chunk(s0, pfa);
      chunk(s0 + 32, pfb);
    }
    __syncthreads();
  }
}

DI void phase_ssd_out(const Params& P, int j) {
  const int lane = ltid() & 63;
  const int gw = lbid() * 4 + (ltid() >> 6), nw = gridDim.x * 4;
  const bf16* Y0 = (const bf16*)(WSP + OFF_H);
  const bf16* Y1 = (const bf16*)(WSP + OFF_BIG) + (size_t)M * D;
  bf16* Zb = (bf16*)(WSP + OFF_BIG) + (size_t)3 * M * D;
  const float* nwp = IN(I_SSDNORM) + j * 1024;
  for (int g = gw; g < M; g += nw) {
    const size_t base = (size_t)g * D + lane * 16;
    float yv[16]; float ss = 0.f;
#pragma unroll
    for (int hh = 0; hh < 2; ++hh) {
      const bf16x8 a = *(const bf16x8*)(Y0 + base + hh * 8), c = *(const bf16x8*)(Y1 + base + hh * 8), z = *(const bf16x8*)(Zb + base + hh * 8);
#pragma unroll
      for (int e = 0; e < 8; ++e) {
        const float v = (bf2f((bf16)a[e]) + bf2f((bf16)c[e])) * siluf(bf2f((bf16)z[e]));
        yv[hh * 8 + e] = v; ss += v * v;
      }
    }
#pragma unroll
    for (int o = 16; o >= 1; o >>= 1) ss += __shfl_xor(ss, o);
    const float rs = rsqrtf(ss * (1.f / 512.f) + 1e-5f);
#pragma unroll
    for (int hh = 0; hh < 2; ++hh) {
      bf16x8 o;
#pragma unroll
      for (int e = 0; e < 8; ++e) o[e] = (short)f2bf(yv[hh * 8 + e] * rs * nwp[lane * 16 + hh * 8 + e]);
      *(bf16x8*)(Zb + base + hh * 8) = o;
    }
  }
}

DI void phase_wkv_scan(const Params& P, int j, char* smem, int cu_idx, int nact) {
  float* sR = (float*)smem;
  float* sKK = sR + 2048;
  float* sW = sKK + 2048;
  float* sBv = sW + 2048;
  float* sKd = sBv + 2048;
  float* sV = sKd + 2048;
  float* sY = sV + 2048;
  float* sKKW = sY + 1024;
  float* sRKW = sKKW + 64;
  const bf16* R = (const bf16*)(WSP + OFF_BIG);
  const bf16* K = R + (size_t)M * D;
  const bf16* V = K + (size_t)M * D;
  const bf16* TW = (const bf16*)(WSP + OFF_TW);
  const bf16* TA = (const bf16*)(WSP + OFF_TA);
  float* RKo = (float*)(WSP + OFF_RK);
  bf16* Y0 = (bf16*)(WSP + OFF_H);
  bf16* Y1 = (bf16*)(WSP + OFF_Y);
  const int tid = ltid(), lane = tid & 63, wave = tid >> 6, l15 = lane & 15, Q = lane >> 4;
  const int prow = tid >> 3, kq = tid & 7;
  if (cu_idx < 0) return;
  for (int item = cu_idx; item < 256; item += nact) {
    const int chain = item >> 1, sp = item & 1;
    const int b = chain >> 5, dir = (chain >> 4) & 1, head = chain & 15;
    const size_t gb = (size_t)b * TB;
    bf16* Yd = dir == 0 ? Y0 : Y1;
    const int hc0 = head * 64;
    const int step = dir == 0 ? 1 : -1;
    bf16x8 Bw[2], Ba[2];
    {
      const float* w2 = IN(I_W2) + (size_t)(j * 2 + dir) * 64 * 1024 + hc0 + wave * 16 + l15;
      const float* a2 = IN(I_A2) + (size_t)(j * 2 + dir) * 64 * 1024 + hc0 + wave * 16 + l15;
#pragma unroll
      for (int ks = 0; ks < 2; ++ks)
#pragma unroll
        for (int jj = 0; jj < 8; ++jj) Bw[ks][jj] = (short)f2bf(w2[(size_t)(ks * 32 + Q * 8 + jj) * 1024]);
#pragma unroll
      for (int ks = 0; ks < 2; ++ks)
#pragma unroll
        for (int jj = 0; jj < 8; ++jj) Ba[ks][jj] = (short)f2bf(a2[(size_t)(ks * 32 + Q * 8 + jj) * 1024]);
    }
    bf16x8* sFr = (bf16x8*)(smem + 55296);
    sFr[tid] = Bw[0]; sFr[256 + tid] = Bw[1]; sFr[512 + tid] = Ba[0]; sFr[768 + tid] = Ba[1];
    const int ccol = hc0 + wave * 16 + l15;
    const float w0c = IN(I_W0)[(j * 2 + dir) * 1024 + ccol];
    const float a0c = IN(I_A0)[(j * 2 + dir) * 1024 + ccol];
    const float kac = IN(I_KA)[j * 1024 + ccol];
    const int myrow = sp * 32 + prow;
    const int ta_t = tid >> 3, ta_c8 = (tid & 7) * 8;
    __syncthreads();
    if (tid < 64) { sKKW[tid] = IN(I_KK)[j * 1024 + hc0 + tid]; sRKW[tid] = IN(I_RK)[j * 1024 + hc0 + tid]; }
    __syncthreads();
    float S[8] = {0.f, 0.f, 0.f, 0.f, 0.f, 0.f, 0.f, 0.f};
    bf16x8 prv, pkv, pvv, pfw[2][2], pfa[2][2];
    auto issue = [&](int s0n) {
      const bool isctx = s0n < CL;
      const int pfirst = dir == 0 ? s0n : (isctx ? 255 - s0n : 8703 - s0n);
      const size_t gi = gb + pfirst + ta_t * step;
      prv = *(const bf16x8*)(R + gi * D + hc0 + ta_c8);
      pkv = *(const bf16x8*)(K + gi * D + hc0 + ta_c8);
      pvv = *(const bf16x8*)(V + gi * D + hc0 + ta_c8);
#pragma unroll
      for (int mt = 0; mt < 2; ++mt) {
        const size_t g2 = gb + pfirst + (mt * 16 + l15) * step;
#pragma unroll
        for (int ks = 0; ks < 2; ++ks) {
          pfw[mt][ks] = *(const bf16x8*)(TW + g2 * 128 + dir * 64 + ks * 32 + Q * 8);
          pfa[mt][ks] = *(const bf16x8*)(TA + g2 * 128 + dir * 64 + ks * 32 + Q * 8);
        }
      }
    };
    issue(0);
    for (int s0 = 0; s0 < TB; s0 += 32) {
      const bool isctx = s0 < CL;
      const int pfirst = dir == 0 ? s0 : (isctx ? 255 - s0 : 8703 - s0);
      {
        float kk[8]; float ss = 0.f;
#pragma unroll
        for (int e = 0; e < 8; ++e) { kk[e] = bf2f((bf16)pkv[e]) * sKKW[ta_c8 + e]; ss += kk[e] * kk[e]; }
        ss = red8(ss);
        const float inv = fminf(__builtin_amdgcn_rsqf(ss), 1e12f);
#pragma unroll
        for (int e = 0; e < 8; ++e) {
          sR[ta_t * 64 + ta_c8 + e] = bf2f((bf16)prv[e]);
          sKd[ta_t * 64 + ta_c8 + e] = bf2f((bf16)pkv[e]);
          sKK[ta_t * 64 + ta_c8 + e] = kk[e] * inv;
          sV[ta_t * 64 + ta_c8 + e] = bf2f((bf16)pvv[e]);
        }
      }
      f32x4 aw[2], aa[2];
#pragma unroll
      for (int mt = 0; mt < 2; ++mt) {
        aw[mt] = f32x4{0.f, 0.f, 0.f, 0.f}; aa[mt] = f32x4{0.f, 0.f, 0.f, 0.f};
#pragma unroll
        for (int ks = 0; ks < 2; ++ks) {
          aw[mt] = MFMA16(pfw[mt][ks], sFr[ks * 256 + tid], aw[mt]);
          aa[mt] = MFMA16(pfa[mt][ks], sFr[512 + ks * 256 + tid], aa[mt]);
        }
      }
      __syncthreads();
      if (s0 + 32 < TB) issue(s0 + 32);
#pragma unroll
      for (int mt = 0; mt < 2; ++mt)
#pragma unroll
        for (int r = 0; r < 4; ++r) {
          const int t = mt * 16 + Q * 4 + r, idx = t * 64 + wave * 16 + l15;
          const float wl = w0c + aw[mt][r];
          const float ee = 0.6065306597f * __builtin_amdgcn_rcpf(1.f + __expf(-wl));
          const float a = __builtin_amdgcn_rcpf(1.f + __expf(-(a0c + aa[mt][r])));
          const float kraw = sKd[idx], kk = sKK[idx];
          sW[idx] = __expf(-ee);
          sBv[idx] = kk * a;
          sKd[idx] = kraw * (1.f + (a - 1.f) * kac);
          sKK[idx] = -kk;
        }
      __syncthreads();
      if (sp == 0) {
        float s = 0.f;
#pragma unroll
        for (int e = 0; e < 8; ++e) s += sR[ta_t * 64 + ta_c8 + e] * sRKW[ta_c8 + e] * sKd[ta_t * 64 + ta_c8 + e];
        s = red8(s);
        if ((tid & 7) == 0) RKo[(gb + pfirst + ta_t * step) * 32 + dir * 16 + head] = s;
      }
      struct OPS { float4 nk0, nk1, wv0, wv1, bv0, bv1, kd0, kd1, rr0, rr1; float vv; };
      OPS oa, ob;
#define WKV_LOAD(o, ii) do { const int in_ = (ii) < 32 ? (ii) : 31; \
        (o).nk0 = *(const float4*)(sKK + in_ * 64 + kq * 8); (o).nk1 = *(const float4*)(sKK + in_ * 64 + kq * 8 + 4); \
        (o).wv0 = *(const float4*)(sW + in_ * 64 + kq * 8);  (o).wv1 = *(const float4*)(sW + in_ * 64 + kq * 8 + 4); \
        (o).bv0 = *(const float4*)(sBv + in_ * 64 + kq * 8); (o).bv1 = *(const float4*)(sBv + in_ * 64 + kq * 8 + 4); \
        (o).kd0 = *(const float4*)(sKd + in_ * 64 + kq * 8); (o).kd1 = *(const float4*)(sKd + in_ * 64 + kq * 8 + 4); \
        (o).rr0 = *(const float4*)(sR + in_ * 64 + kq * 8);  (o).rr1 = *(const float4*)(sR + in_ * 64 + kq * 8 + 4); \
        (o).vv = sV[in_ * 64 + myrow]; } while (0)
#define WKV_STEP(o, ii) do { \
        float sa = ((S[0] * (o).nk0.x + S[1] * (o).nk0.y) + (S[2] * (o).nk0.z + S[3] * (o).nk0.w)) + ((S[4] * (o).nk1.x + S[5] * (o).nk1.y) + (S[6] * (o).nk1.z + S[7] * (o).nk1.w)); \
        sa = red8(sa); \
        S[0] = S[0] * (o).wv0.x + (sa * (o).bv0.x + (o).vv * (o).kd0.x); S[1] = S[1] * (o).wv0.y + (sa * (o).bv0.y + (o).vv * (o).kd0.y); \
        S[2] = S[2] * (o).wv0.z + (sa * (o).bv0.z + (o).vv * (o).kd0.z); S[3] = S[3] * (o).wv0.w + (sa * (o).bv0.w + (o).vv * (o).kd0.w); \
        S[4] = S[4] * (o).wv1.x + (sa * (o).bv1.x + (o).vv * (o).kd1.x); S[5] = S[5] * (o).wv1.y + (sa * (o).bv1.y + (o).vv * (o).kd1.y); \
        S[6] = S[6] * (o).wv1.z + (sa * (o).bv1.z + (o).vv * (o).kd1.z); S[7] = S[7] * (o).wv1.w + (sa * (o).bv1.w + (o).vv * (o).kd1.w); \
        float y = ((S[0] * (o).rr0.x + S[1] * (o).rr0.y) + (S[2] * (o).rr0.z + S[3] * (o).rr0.w)) + ((S[4] * (o).rr1.x + S[5] * (o).rr1.y) + (S[6] * (o).rr1.z + S[7] * (o).rr1.w)); \
        y = red8(y); \
        if (kq == 0) sY[(ii) * 32 + prow] = y; } while (0)
      WKV_LOAD(oa, 0);
#pragma unroll 2
      for (int i = 0; i < 32; i += 2) {
        WKV_LOAD(ob, i + 1);
        WKV_STEP(oa, i);
        WKV_LOAD(oa, i + 2);
        WKV_STEP(ob, i + 1);
      }
#undef WKV_LOAD
#undef WKV_STEP
      __syncthreads();
      {
        const int i = tid >> 3, r4 = (tid & 7) * 4;
        const int p = pfirst + i * step;
        bf16x4 o;
        o[0] = (short)f2bf(sY[i * 32 + r4]); o[1] = (short)f2bf(sY[i * 32 + r4 + 1]); o[2] = (short)f2bf(sY[i * 32 + r4 + 2]); o[3] = (short)f2bf(sY[i * 32 + r4 + 3]);
        *(bf16x4*)(Yd + (gb + p) * D + hc0 + sp * 32 + r4) = o;
      }
    }
    __syncthreads();
  }
}

DI void phase_wkv_out(const Params& P, int j) {
  const int lane = ltid() & 63;
  const int gw = lbid() * 4 + (ltid() >> 6), nw = gridDim.x * 4;
  const bf16* Y0 = (const bf16*)(WSP + OFF_H);
  const bf16* Y1 = (const bf16*)(WSP + OFF_Y);
  bf16* R = (bf16*)(WSP + OFF_BIG);
  const bf16* V = R + (size_t)2 * M * D;
  const float* RKi = (const float*)(WSP + OFF_RK);
  const float* lnw = IN(I_LNW) + j * 1024;
  const float* lnb = IN(I_LNB) + j * 1024;
  for (int g = gw; g < M; g += nw) {
    const size_t base = (size_t)g * D + lane * 16;
    const int head = lane >> 2;
    float yv[16], vv[16]; float s = 0.f;
#pragma unroll
    for (int hh = 0; hh < 2; ++hh) {
      const bf16x8 a = *(const bf16x8*)(Y0 + base + hh * 8), c = *(const bf16x8*)(Y1 + base + hh * 8), v = *(const bf16x8*)(V + base + hh * 8);
#pragma unroll
      for (int e = 0; e < 8; ++e) { yv[hh * 8 + e] = bf2f((bf16)a[e]) + bf2f((bf16)c[e]); vv[hh * 8 + e] = bf2f((bf16)v[e]); s += yv[hh * 8 + e]; }
    }
    s = red4(s);
    const float mean = s * (1.f / 64.f);
    float q = 0.f;
#pragma unroll
    for (int e = 0; e < 16; ++e) { const float d = yv[e] - mean; q += d * d; }
    q = red4(q);
    const float rs = rsqrtf(q * (1.f / 64.f) + 64e-5f);
    const float rk = RKi[(size_t)g * 32 + head] + RKi[(size_t)g * 32 + 16 + head];
#pragma unroll
    for (int hh = 0; hh < 2; ++hh) {
      bf16x8 o;
#pragma unroll
      for (int e = 0; e < 8; ++e) {
        const int c = lane * 16 + hh * 8 + e;
        o[e] = (short)f2bf((yv[hh * 8 + e] - mean) * rs * lnw[c] + lnb[c] + rk * vv[hh * 8 + e]);
      }
      *(bf16x8*)(R + base + hh * 8) = o;
    }
  }
}

#define XB_TMO      128
#define XB_XCNT(j)  (256  + 64 * (j))
#define XB_XSUB(j)  (1280 + 64 * (j))
#define XB_XGEN(j)  (2304 + 64 * (j))
#define XB_TOP      3328
#define XB_TOPGEN   3392
#define XCD_BAR_WORDS 3456
#define XB_SPIN_CAP (1u << 23)
#define LAS __attribute__((address_space(3)))

__device__ __forceinline__ unsigned xb_ld(unsigned* p)              { return __hip_atomic_load(p, __ATOMIC_RELAXED, __HIP_MEMORY_SCOPE_AGENT); }
__device__ __forceinline__ unsigned xb_add(unsigned* p, unsigned v) { return __hip_atomic_fetch_add(p, v, __ATOMIC_RELAXED, __HIP_MEMORY_SCOPE_AGENT); }
__device__ __forceinline__ unsigned xb_xcc_id() { return (unsigned)__builtin_amdgcn_s_getreg((3 << 11) | 20) & 0xFu; }
#define XB_SPIN(cond, bar) do { unsigned _sp = 0; while (cond) { __builtin_amdgcn_s_sleep(1); \
    if ((++_sp & 255u) == 0u) { if (xb_ld(&(bar)[XB_TMO])) break; if (_sp > XB_SPIN_CAP) { atomicAdd(&(bar)[XB_TMO], 1u); break; } } } } while (0)

struct XcdBarrier {
    unsigned* bar; unsigned x;
    volatile LAS unsigned* st;
};

__device__ __forceinline__ XcdBarrier xcd_barrier_post(unsigned* bar, volatile LAS unsigned* st) {
    XcdBarrier b; b.bar = bar; b.x = xb_xcc_id(); b.st = st;
    if (threadIdx.x == 0) (void)xb_add(&bar[XB_XCNT(b.x)], 1u);
    return b;
}
__device__ __forceinline__ void xcd_barrier_complete(unsigned* bar, unsigned x, unsigned& nloc, unsigned& nx) {
    const unsigned G = gridDim.x * gridDim.y * gridDim.z;
    unsigned sum, cnt, mine, sp = 0u;
    for (;;) {
        sum = 0u; cnt = 0u; mine = 0u;
#pragma unroll
        for (unsigned j = 0; j < 16; ++j) { const unsigned c = xb_ld(&bar[XB_XCNT(j)]); sum += c; cnt += (c > 0u) ? 1u : 0u; mine = (j == x) ? c : mine; }
        if (sum == G) break;
        __builtin_amdgcn_s_sleep(1);
        if ((++sp & 255u) == 0u) { if (xb_ld(&bar[XB_TMO])) break; if (sp > XB_SPIN_CAP) { atomicAdd(&bar[XB_TMO], 1u); break; } }
    }
    nloc = mine > 0u ? mine : 1u; nx = cnt > 0u ? cnt : 1u;
}

__device__ __forceinline__ void xcd_barrier(const XcdBarrier& b) {
    asm volatile("s_waitcnt vmcnt(0)" ::: "memory");
    __syncthreads();
    if (threadIdx.x == 0) {
        unsigned* bar = b.bar;
        __builtin_amdgcn_s_waitcnt(0);
        unsigned nloc = b.st[0], nx = b.st[1];
        if (nloc == 0u) { xcd_barrier_complete(bar, b.x, nloc, nx); b.st[0] = nloc; b.st[1] = nx; }
        const unsigned old = xb_add(&bar[XB_XSUB(b.x)], 1u);
        const unsigned gen = old / nloc;
        if (old + 1u == (gen + 1u) * nloc) {
            __builtin_amdgcn_fence(__ATOMIC_RELEASE, "agent");
            asm volatile("s_waitcnt vmcnt(0)" ::: "memory");
            const unsigned og = xb_add(&bar[XB_TOP], 1u);
            const unsigned tg = og / nx;
            if (og + 1u == (tg + 1u) * nx) xb_add(&bar[XB_TOPGEN], 1u);
            else XB_SPIN(xb_ld(&bar[XB_TOPGEN]) == tg, bar);
            __builtin_amdgcn_fence(__ATOMIC_ACQUIRE, "agent");
            xb_add(&bar[XB_XGEN(b.x)], 1u);
            asm volatile("s_waitcnt vmcnt(0)" ::: "memory");
        } else {
            XB_SPIN(xb_ld(&bar[XB_XGEN(b.x)]) == gen, bar);
            __builtin_amdgcn_fence(__ATOMIC_ACQUIRE, "agent");
            asm volatile("s_waitcnt vmcnt(0)" ::: "memory");
        }
    }
    __syncthreads();
}


enum { OP_NOP = 0, OP_INIT, OP_CONVERT, OP_POSTPRE, OP_FFN_IN, OP_FFN_OUT, OP_EVENIN, OP_ATTN, OP_SSD, OP_SSDOUT, OP_EVENOUT,
       OP_MIX, OP_VMIX, OP_WKV, OP_WKVOUT, OP_GMUL, OP_WO, OP_BCCONV };
enum { KG_NONE = 0, KG_SWIGLU, KG_STORE, KG_EVENIN, KG_MIX, KG_MIXS, KG_VMIX, KG_GMUL };

__global__ void __launch_bounds__(256, 2) mega_kernel(Params P0) {
  cg::grid_group grid = cg::this_grid();
  __shared__ __attribute__((aligned(16))) char smem[73728];
  __shared__ Params sP;
  if (threadIdx.x < 40) sP.in[threadIdx.x] = P0.in[threadIdx.x];
  if (threadIdx.x == 40) sP.xlat = P0.xlat;
  if (threadIdx.x == 41) sP.ws = P0.ws;
  __shared__ uint4 xb_words;
  if (threadIdx.x == 0) xb_words = make_uint4(0u, 0u, 0u, 0u);
  __syncthreads();
  XcdBarrier xb = xcd_barrier_post((unsigned*)(P0.ws + OFF_BAR), (volatile LAS unsigned*)&xb_words);
  __shared__ int s_cu_idx, s_r1_idx;
  if (threadIdx.x == 0) {
    unsigned* tab = (unsigned*)(P0.ws + OFF_CENSUS);
    const unsigned hw = (unsigned)__builtin_amdgcn_s_getreg((15 << 11) | 4);
    const unsigned key = xb_xcc_id() * 256u + ((hw >> 8) & 0xFFu);
    const unsigned r = xb_add(&tab[key], 1u);
    s_cu_idx = (r == 0u) ? (int)xb_add(&tab[2048], 1u) : -1;
    s_r1_idx = (r == 0u) ? -1 : (int)xb_add(&tab[2049], 1u);
  }
  __syncthreads();
  const Params& P = sP;
#pragma unroll 1
  for (int pc = -3; pc < 80; ++pc) {
    bf16* H = (bf16*)(WSP + OFF_H);
    bf16* Y = (bf16*)(WSP + OFF_Y);
    bf16* BIG = (bf16*)(WSP + OFF_BIG);
    const bf16* W = (const bf16*)(WSP + OFF_W) + (size_t)((pc < 0 ? 0 : pc / 20) & 1) * W_STRIDE;
    int op = OP_NOP, arg = 0, sync = 0, l = 0;
    if (pc == -3) { op = OP_INIT; sync = 1; }
    else if (pc == -2) { op = OP_CONVERT; arg = 0; }
    else if (pc == -1) { op = OP_POSTPRE; arg = 3; sync = 1; }
    else {
      l = pc / 20;
      const int s = pc - l * 20;
      const bool odd = (l & 1) != 0;
      const int j = l >> 1;
      if (s == 0) { op = OP_FFN_IN; arg = 0; sync = 1; }
      else if (s == 1) { op = OP_FFN_OUT; arg = 0; sync = 1; }
      else if (s == 2) { op = OP_POSTPRE; arg = 0; sync = 1; }
      else if (s <= 14) {
        if (!odd) {
          if (s == 3) { op = OP_EVENIN; sync = 1; } else if (s == 4) { op = OP_ATTN; sync = 1; } else if (s == 5) { op = OP_BCCONV; sync = 1; }
          else if (s == 6) { op = OP_SSD; sync = 1; } else if (s == 7) { op = OP_SSDOUT; sync = 1; } else if (s == 8) { op = OP_EVENOUT; sync = 1; }
        } else {
          if (s <= 9) { op = OP_MIX; arg = s - 3; sync = (s == 9); if (arg == 6 && j == 0) op = OP_NOP; }
          else if (s == 10) { if (j > 0) { op = OP_VMIX; sync = 1; } }
          else if (s == 11) { op = OP_WKV; sync = 1; } else if (s == 12) { op = OP_WKVOUT; sync = 1; }
          else if (s == 13) { op = OP_GMUL; sync = 1; } else { op = OP_WO; sync = 1; }
        }
      }
      else if (s == 15) { op = OP_POSTPRE; arg = 1; sync = 1; }
      else if (s == 16) { op = OP_FFN_IN; arg = 1; sync = 1; }
      else if (s == 17) { op = OP_FFN_OUT; arg = 1; sync = 1; }
      else if (s == 18) { }
      else { op = OP_POSTPRE; arg = 2; sync = 1; }
    }
    const int j = l >> 1;
#ifndef PROBE_DUP
#define PROBE_DUP 0
#endif
    const int reps = ((PROBE_DUP >> op) & 1) ? 2 : 1;
#pragma unroll 1
    for (int rep = 0; rep < reps; ++rep) {
    GA g = make_ga(H, 1024, W, 1024, 1024, Y, 1024);
    int kind = KG_NONE;
    switch (op) {
      case OP_INIT: phase_init(P, smem); break;
      case OP_CONVERT: phase_convert(P, arg, lbid(), gridDim.x); break;
      case OP_POSTPRE:
        if (arg == 3) phase_postpre(P, false, 0, 0, 0.f, true, 0, 0);
        else if (arg == 0) phase_postpre(P, true, l, 0, 0.5f, true, l, 1);
        else if (arg == 1) phase_postpre(P, true, l, 1, 1.0f, true, l, 2);
        else phase_postpre(P, true, l, 2, 0.5f, l < 3, l + 1, 0);
        break;
      case OP_FFN_IN: g = make_ga(H, 1024, W + (arg ? W_FIN1 : W_FIN0), 1024, 5632, BIG, FH); kind = KG_SWIGLU; break;
      case OP_FFN_OUT: g = make_ga(BIG, FH, W + (arg ? W_FOUT1 : W_FOUT0), FH, 1024, Y, 1024); kind = KG_STORE; break;
      case OP_EVENIN: g = make_ga(H, 1024, W + W_EIN, 1024, 5888, nullptr, 0); kind = KG_EVENIN; break;
      case OP_ATTN: phase_attn(P, j, l, smem, rep + 1 < reps); break;
      case OP_SSD: {
        const int nact = (int)xb_ld((unsigned*)(WSP + OFF_CENSUS) + 2048), nr1 = (int)gridDim.x - nact, nit = nact < 128 ? nact : 128;
        const bool scanner = s_cu_idx >= 0 && s_cu_idx < 128;
        const int ncv = (int)gridDim.x - nit;
        if (scanner) phase_ssd_chunk(P, j, smem, s_cu_idx, nit);
        if (l < 3 && (!scanner || ncv == 0))
          phase_convert(P, l + 1, ncv == 0 ? lbid() : (s_cu_idx < 0 ? s_r1_idx : nr1 + s_cu_idx - 128), ncv == 0 ? (int)gridDim.x : ncv);
      } break;
      case OP_BCCONV: phase_bcconv(P, j); break;
      case OP_SSDOUT: phase_ssd_out(P, j); break;
      case OP_EVENOUT: g = make_ga(BIG, 1024, W + W_EOUT, 2048, 1024, Y, 1024); g.A2 = BIG + (size_t)3 * M * D; g.ksplit = 1024; kind = KG_STORE; break;
      case OP_MIX: {
        const float* mu = IN(I_MU) + (size_t)j * 6 * 1024;
        bf16* R = BIG; bf16* K = BIG + (size_t)M * D; bf16* V = BIG + (size_t)2 * M * D;
        if (arg == 0) { g = make_ga(H, 1024, W + W_R, 1024, 1024, R, 1024); g.mu = mu; }
        else if (arg == 1) { g = make_ga(H, 1024, W + W_K, 1024, 1024, K, 1024); g.mu = mu + 2 * 1024; }
        else if (arg == 2) { g = make_ga(H, 1024, W + W_V, 1024, 1024, V, 1024); g.mu = mu + 3 * 1024; if (j == 0) g.o1 = (bf16*)(WSP + OFF_VF); }
        else if (arg == 3) { g = make_ga(H, 1024, W + W_W1, 1024, 128, (bf16*)(WSP + OFF_TW), 128); g.mu = mu + 1 * 1024; g.act = 1; }
        else if (arg == 4) { g = make_ga(H, 1024, W + W_A1, 1024, 128, (bf16*)(WSP + OFF_TA), 128); g.mu = mu + 4 * 1024; }
        else if (arg == 5) { g = make_ga(H, 1024, W + W_G1, 1024, 160, (bf16*)(WSP + OFF_TG), 160); g.mu = mu + 5 * 1024; g.act = 2; }
        else { g = make_ga(H, 1024, W + W_V1, 1024, 32, (bf16*)(WSP + OFF_TV), 32); g.mu = mu + 3 * 1024; }
        g.ksplit = arg == 0 ? 0 : arg == 1 ? 2112 : arg == 2 ? 4224 : arg == 3 ? 6336 : arg == 4 ? 6600 : arg == 5 ? 6864 : 7392;
        kind = KG_MIXS;
      } break;
      case OP_VMIX: g = make_ga((bf16*)(WSP + OFF_TV), 32, W + W_V2, 32, 1024, BIG + (size_t)2 * M * D, 1024); g.f0 = IN(I_V0) + (size_t)(j - 1) * 1024; kind = KG_VMIX; break;
      case OP_WKV: {
        const int nact = (int)xb_ld((unsigned*)(WSP + OFF_CENSUS) + 2048), nr1 = (int)gridDim.x - nact, nit = nact < 256 ? nact : 256;
        const bool scanner = s_cu_idx >= 0 && s_cu_idx < 256;
        const int ncv = (int)gridDim.x - nit;
        if (scanner) phase_wkv_scan(P, j, smem, s_cu_idx, nit);
        if (l < 3 && (!scanner || ncv == 0))
          phase_convert(P, l + 1, ncv == 0 ? lbid() : (s_cu_idx < 0 ? s_r1_idx : nr1 + s_cu_idx - 256), ncv == 0 ? (int)gridDim.x : ncv);
      } break;
      case OP_WKVOUT: phase_wkv_out(P, j); break;
      case OP_GMUL: g = make_ga((bf16*)(WSP + OFF_TG), 160, W + W_G2, 160, 1024, BIG, 1024); kind = KG_GMUL; break;
      case OP_WO: g = make_ga(BIG, 1024, W + W_O, 1024, 1024, Y, 1024); kind = KG_STORE; break;
      default: break;
    }
    switch (kind) {
      case KG_SWIGLU: gemm_phase<32, 0, EPI_SWIGLU, 8>(P, g, smem); break;
      case KG_STORE: gemm_phase<64, 0, EPI_STORE, 4>(P, g, smem); break;
      case KG_EVENIN: gemm_phase<64, 0, EPI_EVENIN, 4>(P, g, smem); break;

      case KG_MIXS: gemm_phase<64, 1, EPI_STORE, 4>(P, g, smem); break;
      case KG_VMIX: gemm_phase<32, 0, EPI_VMIX, 8>(P, g, smem); break;
      case KG_GMUL: gemm_phase<32, 0, EPI_GMUL, 8>(P, g, smem); break;
      default: break;
    }
    if (sync || rep + 1 < reps) { if (pc == -3) grid.sync(); else xcd_barrier(xb); }
    }
  }
}

extern "C" void kernel_launch(void* const* d_in, const int* in_sizes, int n_in, void* d_out, int out_size, void* d_ws, size_t ws_size,
                              hipStream_t stream) {
  static int grid_blocks = 0;
  if (!grid_blocks) {
    int dev = 0, cus = 0, per_cu = 0;
    hipGetDevice(&dev);
    hipDeviceGetAttribute(&cus, hipDeviceAttributeMultiprocessorCount, dev);
    hipOccupancyMaxActiveBlocksPerMultiprocessor(&per_cu, mega_kernel, 256, 0);
    if (per_cu > 2) per_cu = 2;
    if (per_cu < 1) per_cu = 1;
    grid_blocks = cus * per_cu;
  }
  if (ws_size < WS_NEED) fprintf(stderr, "workspace too small: %zu < %zu\n", ws_size, (size_t)WS_NEED);
  Params p;
  memset(&p, 0, sizeof(p));
  for (int i = 0; i < 40; ++i) p.in[i] = (const float*)d_in[i];
  p.xlat = (float*)d_out;
  p.ws = (char*)d_ws;
  hipMemsetAsync((char*)d_ws + OFF_BAR, 0, 32768, stream);
  void* args[] = {&p};
  hipError_t e = hipLaunchCooperativeKernel((void*)mega_kernel, dim3(grid_blocks), dim3(256), args, 0, stream);
  if (e != hipSuccess) fprintf(stderr, "cooperative launch failed: %s (grid %d)\n", hipGetErrorString(e), grid_blocks);
}
```

```cpp
#include <hip/hip_runtime.h>
#include <hip/hip_cooperative_groups.h>
#include <cstdio>
#include <cstring>
#include <cstdint>
namespace cg = cooperative_groups;

typedef unsigned short bf16;
using bf16x8 = __attribute__((ext_vector_type(8))) short;
using bf16x4 = __attribute__((ext_vector_type(4))) short;
using f32x4 = __attribute__((ext_vector_type(4))) float;
#define DI __device__ __forceinline__

constexpr int D = 1024, NB = 4, CL = 256, TB = 8448, M = 33792, FH = 2816;
constexpr size_t U = (size_t)M * D * 2;

constexpr size_t OFF_H = 0;
constexpr size_t OFF_Y = U;
constexpr size_t OFF_BIG = 2 * U;
constexpr size_t OFF_VF = OFF_BIG + 4 * U + U / 2;
constexpr size_t OFF_W = OFF_VF + U;
constexpr size_t W_STRIDE = 25432064;
constexpr size_t W_ELEMS = 2 * W_STRIDE;
constexpr size_t OFF_TW = OFF_W + W_ELEMS * 2;
constexpr size_t OFF_TA = OFF_TW + (size_t)M * 128 * 2;
constexpr size_t OFF_TG = OFF_TA + (size_t)M * 128 * 2;
constexpr size_t OFF_TV = OFF_TG + (size_t)M * 160 * 2;
constexpr size_t OFF_DT = OFF_TV + (size_t)M * 32 * 2;
constexpr size_t OFF_RK = OFF_DT + (size_t)M * 32 * 4;
constexpr size_t OFF_XCTX = OFF_RK + (size_t)M * 32 * 4;
constexpr size_t OFF_MOD = OFF_XCTX + (size_t)NB * CL * D * 4;
constexpr size_t OFF_ROPE = OFF_MOD + (size_t)4 * 5 * 9216 * 4;
constexpr size_t OFF_BAR = OFF_ROPE + (size_t)128 * 16 * 2 * 4;
constexpr size_t OFF_CENSUS = OFF_BAR + 16384;
constexpr size_t WS_NEED = OFF_CENSUS + 16384;

constexpr size_t W_FIN0 = 0, W_FOUT0 = 5767168, W_FIN1 = 8650752, W_FOUT1 = 14417920, W_MIX = 17301504;
constexpr size_t W_EIN = W_MIX, W_EOUT = W_MIX + 6029312;
constexpr size_t W_R = W_MIX, W_K = W_R + 1048576, W_V = W_K + 1048576, W_O = W_V + 1048576, W_W1 = W_O + 1048576,
                 W_A1 = W_W1 + 131072, W_G1 = W_A1 + 131072, W_V1 = W_G1 + 163840, W_G2 = W_V1 + 32768, W_V2 = W_G2 + 163840;

struct Params {
  const float* in[40];
  float* xlat;
  char* ws;
};

enum { I_X = 0, I_C, I_CTX, I_CCTX, I_ADAW, I_ADAB, I_NORMW, I_FWIN, I_FWOUT, I_EWIN, I_EWOUT, I_LAMBDA, I_SUBLN, I_CONVW, I_CONVB,
       I_DTBIAS, I_ALOG, I_SSDD, I_SSDNORM, I_MU, I_WR, I_WK, I_WV, I_WO, I_W0, I_W1, I_W2, I_A0, I_A1, I_A2, I_G1, I_G2,
       I_KK, I_KA, I_RK, I_LNW, I_LNB, I_V0, I_V1, I_V2 };

DI const void* rfl_ptr(const void* p) {
  unsigned lo = (unsigned)(size_t)p, hi = (unsigned)((size_t)p >> 32);
  lo = __builtin_amdgcn_readfirstlane(lo); hi = __builtin_amdgcn_readfirstlane(hi);
  return (const void*)(__attribute__((address_space(1))) const char*)(((size_t)hi << 32) | (size_t)lo);
}
#define IN(i) ((const float*)rfl_ptr((const void*)P.in[i]))
#define WSP ((char*)rfl_ptr((const void*)P.ws))
#define XLATP ((float*)rfl_ptr((const void*)P.xlat))
DI int ltid() { int t = threadIdx.x; asm volatile("" : "+v"(t)); return t; }
DI int lbid() { int t = blockIdx.x; asm volatile("" : "+s"(t)); return t; }
DI bf16 f2bf(float x) { __bf16 r = (__bf16)x; return __builtin_bit_cast(unsigned short, r); }
DI float bf2f(bf16 v) { return __uint_as_float(((unsigned)v) << 16); }
DI float siluf(float x) { return x / (1.f + __expf(-x)); }
DI float sigmoidf(float x) { return 1.f / (1.f + __expf(-x)); }
DI float softplusf(float x) { return x > 20.f ? x : log1pf(expf(x)); }
template <int CTRL> DI float dppf(float v) { return __int_as_float(__builtin_amdgcn_update_dpp(0, __float_as_int(v), CTRL, 0xf, 0xf, false)); }
DI float red4(float v) { v += dppf<0xB1>(v); v += dppf<0x4E>(v); return v; }
DI float red8(float v) { v = red4(v); v += dppf<0x141>(v); return v; }
DI float red16(float v) { v = red8(v); v += dppf<0x128>(v); return v; }
DI float wave_sum(float v) {
#pragma unroll
  for (int o = 32; o >= 1; o >>= 1) v += __shfl_xor(v, o);
  return v;
}
DI float* xrow(const Params& P, int g) {
  int b = g / TB, p = g - b * TB;
  return p < CL ? (float*)(WSP + OFF_XCTX) + ((size_t)(b * CL + p)) * D : XLATP + ((size_t)b * 8192 + (p - CL)) * D;
}
#define MFMA16(a, b, c) __builtin_amdgcn_mfma_f32_16x16x32_bf16((a), (b), (c), 0, 0, 0)

DI void phase_init(const Params& P, char* smem) {
  const int tid = ltid(), lane = tid & 63, wave = tid >> 6;
  float* sil = (float*)smem;
  float* red = sil + 5 * 1024;
  const float* c = IN(I_C);
  const float* cc = IN(I_CCTX);
  for (int i = tid; i < 5 * 1024; i += 256) {
    int r = i >> 10, k = i & 1023;
    float x = r < 4 ? c[r * 1024 + k] : cc[k];
    sil[i] = x / (1.f + expf(-x));
  }
  __syncthreads();
  float* mod = (float*)(WSP + OFF_MOD);
  for (int item = lbid(); item < 576; item += gridDim.x) {
    int l = item / 144, n = (item % 144) * 64 + lane;
    const float* w = IN(I_ADAW) + (size_t)l * 1024 * 9216 + n;
    float a0 = 0.f, a1 = 0.f, a2 = 0.f, a3 = 0.f, a4 = 0.f;
#pragma unroll 8
    for (int k = wave * 256; k < wave * 256 + 256; ++k) {
      float wv = w[(size_t)k * 9216];
      a0 += sil[k] * wv; a1 += sil[1024 + k] * wv; a2 += sil[2048 + k] * wv; a3 += sil[3072 + k] * wv; a4 += sil[4096 + k] * wv;
    }
    red[(wave * 5 + 0) * 64 + lane] = a0; red[(wave * 5 + 1) * 64 + lane] = a1; red[(wave * 5 + 2) * 64 + lane] = a2;
    red[(wave * 5 + 3) * 64 + lane] = a3; red[(wave * 5 + 4) * 64 + lane] = a4;
    __syncthreads();
    if (wave == 0) {
      float bias = IN(I_ADAB)[l * 9216 + n];
#pragma unroll
      for (int r = 0; r < 5; ++r) {
        float s = red[r * 64 + lane] + red[(5 + r) * 64 + lane] + red[(10 + r) * 64 + lane] + red[(15 + r) * 64 + lane] + bias;
        mod[((size_t)(l * 5 + r)) * 9216 + n] = s;
      }
    }
    __syncthreads();
  }
  if (lbid() == 0) {
    float* cosT = (float*)(WSP + OFF_ROPE);
    float* sinT = cosT + 2048;
    for (int i = tid; i < 2048; i += 256) {
      int pos = i >> 4, f = i & 15;
      float inv = powf(10000.f, -(float)f / 16.f);
      float ang = (float)pos * inv;
      cosT[i] = cosf(ang); sinT[i] = sinf(ang);
    }
  }
}

DI void conv_job(const float* src, int ld, int K, int Nsrc, int Ndst, bf16* dst, int mapmode, int cbid, int cnb) {
  const size_t gt = (size_t)cbid * 256 + ltid(), gn = (size_t)cnb * 256;
  const size_t total = (size_t)Ndst * (K / 8);
  for (size_t id = gt; id < total; id += gn) {
    int n = (int)(id % Ndst), kc = (int)(id / Ndst);
    int col = n;
    if (mapmode == 1) { int j = 16 * (n >> 5) + (n & 15); col = ((n >> 4) & 1) ? FH + j : j; }
    bf16x8 o;
    if (n < Nsrc) {
      const float* s = src + (size_t)(kc * 8) * ld + col;
#pragma unroll
      for (int jj = 0; jj < 8; ++jj) o[jj] = (short)f2bf(s[(size_t)jj * ld]);
    } else {
#pragma unroll
      for (int jj = 0; jj < 8; ++jj) o[jj] = 0;
    }
    *(bf16x8*)(dst + (size_t)n * K + kc * 8) = o;
  }
}

DI void phase_convert(const Params& P, int l, int cbid, int cnb) {
  bf16* W = (bf16*)(WSP + OFF_W) + (size_t)(l & 1) * W_STRIDE;
  conv_job(IN(I_FWIN) + (size_t)(l * 2 + 0) * 1024 * 5632, 5632, 1024, 5632, 5632, W + W_FIN0, 1, cbid, cnb);
  conv_job(IN(I_FWOUT) + (size_t)(l * 2 + 0) * FH * 1024, 1024, FH, 1024, 1024, W + W_FOUT0, 0, cbid, cnb);
  conv_job(IN(I_FWIN) + (size_t)(l * 2 + 1) * 1024 * 5632, 5632, 1024, 5632, 5632, W + W_FIN1, 1, cbid, cnb);
  conv_job(IN(I_FWOUT) + (size_t)(l * 2 + 1) * FH * 1024, 1024, FH, 1024, 1024, W + W_FOUT1, 0, cbid, cnb);
  const int j = l >> 1;
  if ((l & 1) == 0) {
    conv_job(IN(I_EWIN) + (size_t)j * 1024 * 5664, 5664, 1024, 5664, 5888, W + W_EIN, 0, cbid, cnb);
    conv_job(IN(I_EWOUT) + (size_t)j * 2048 * 1024, 1024, 2048, 1024, 1024, W + W_EOUT, 0, cbid, cnb);
  } else {
    conv_job(IN(I_WR) + (size_t)j * 1048576, 1024, 1024, 1024, 1024, W + W_R, 0, cbid, cnb);
    conv_job(IN(I_WK) + (size_t)j * 1048576, 1024, 1024, 1024, 1024, W + W_K, 0, cbid, cnb);
    conv_job(IN(I_WV) + (size_t)j * 1048576, 1024, 1024, 1024, 1024, W + W_V, 0, cbid, cnb);
    conv_job(IN(I_WO) + (size_t)j * 1048576, 1024, 1024, 1024, 1024, W + W_O, 0, cbid, cnb);
    for (int e = 0; e < 2; ++e) {
      conv_job(IN(I_W1) + (size_t)(j * 2 + e) * 65536, 64, 1024, 64, 64, W + W_W1 + e * 65536, 0, cbid, cnb);
      conv_job(IN(I_A1) + (size_t)(j * 2 + e) * 65536, 64, 1024, 64, 64, W + W_A1 + e * 65536, 0, cbid, cnb);
    }
    conv_job(IN(I_G1) + (size_t)j * 163840, 160, 1024, 160, 160, W + W_G1, 0, cbid, cnb);
    conv_job(IN(I_G2) + (size_t)j * 163840, 1024, 160, 1024, 1024, W + W_G2, 0, cbid, cnb);
    if (j > 0) {
      conv_job(IN(I_V1) + (size_t)(j - 1) * 32768, 32, 1024, 32, 32, W + W_V1, 0, cbid, cnb);
      conv_job(IN(I_V2) + (size_t)(j - 1) * 32768, 1024, 32, 1024, 1024, W + W_V2, 0, cbid, cnb);
    }
  }
}

DI void phase_postpre(const Params& P, bool do_post, int lpost, int spost, float wgt, bool do_pre, int lpre, int spre, bool from_in) {
  const int lane = ltid() & 63;
  const int gw = lbid() * 4 + (ltid() >> 6), nw = gridDim.x * 4;
  const float* mod = (const float*)(WSP + OFF_MOD);
  const bf16* Y = (const bf16*)(WSP + OFF_Y);
  bf16* H = (bf16*)(WSP + OFF_H);
  for (int g = gw; g < M; g += nw) {
    const int b = g / TB, p = g - b * TB, r5 = p < CL ? 4 : b;
    float* x = xrow(P, g);
    float4 xq[4], gq[4], nq[4], shq[4], scq[4], npq[4];
    bf16x4 yq[4];
    const float* xin = from_in ? (p < CL ? IN(I_CTX) + ((size_t)(b * CL + p)) * D : IN(I_X) + ((size_t)b * 8192 + (p - CL)) * D) : x;
#pragma unroll
    for (int i = 0; i < 4; ++i) xq[i] = *(const float4*)(xin + i * 256 + lane * 4);
    if (do_post) {
      const float* gate = mod + ((size_t)(lpost * 5 + r5) * 9 + 3 * spost + 2) * 1024;
      const float* nwp = IN(I_NORMW) + (size_t)(lpost * 6 + 2 * spost + 1) * 1024;
#pragma unroll
      for (int i = 0; i < 4; ++i) {
        yq[i] = *(const bf16x4*)(Y + (size_t)g * D + i * 256 + lane * 4);
        gq[i] = *(const float4*)(gate + i * 256 + lane * 4);
        nq[i] = *(const float4*)(nwp + i * 256 + lane * 4);
      }
    }
    if (do_pre) {
      const float* shift = mod + ((size_t)(lpre * 5 + r5) * 9 + 3 * spre) * 1024;
      const float* nwp = IN(I_NORMW) + (size_t)(lpre * 6 + 2 * spre) * 1024;
#pragma unroll
      for (int i = 0; i < 4; ++i) {
        shq[i] = *(const float4*)(shift + i * 256 + lane * 4);
        scq[i] = *(const float4*)(shift + 1024 + i * 256 + lane * 4);
        npq[i] = *(const float4*)(nwp + i * 256 + lane * 4);
      }
    }
    float xv[16];
#pragma unroll
    for (int i = 0; i < 4; ++i) { xv[4 * i] = xq[i].x; xv[4 * i + 1] = xq[i].y; xv[4 * i + 2] = xq[i].z; xv[4 * i + 3] = xq[i].w; }
    if (do_post) {
      float yv[16]; float ss = 0.f;
#pragma unroll
      for (int i = 0; i < 4; ++i)
#pragma unroll
        for (int e = 0; e < 4; ++e) { const float v = bf2f((bf16)yq[i][e]); yv[4 * i + e] = v; ss += v * v; }
      ss = wave_sum(ss);
      const float rs = rsqrtf(ss * (1.f / 1024.f) + 1e-6f);
#pragma unroll
      for (int i = 0; i < 4; ++i) {
        xv[4 * i] += wgt * gq[i].x * (yv[4 * i] * rs * nq[i].x);
        xv[4 * i + 1] += wgt * gq[i].y * (yv[4 * i + 1] * rs * nq[i].y);
        xv[4 * i + 2] += wgt * gq[i].z * (yv[4 * i + 2] * rs * nq[i].z);
        xv[4 * i + 3] += wgt * gq[i].w * (yv[4 * i + 3] * rs * nq[i].w);
      }
#pragma unroll
      for (int i = 0; i < 4; ++i) *(float4*)(x + i * 256 + lane * 4) = make_float4(xv[4 * i], xv[4 * i + 1], xv[4 * i + 2], xv[4 * i + 3]);
    }
    if (do_pre) {
      float ss = 0.f;
#pragma unroll
      for (int i = 0; i < 16; ++i) ss += xv[i] * xv[i];
      ss = wave_sum(ss);
      const float rs = rsqrtf(ss * (1.f / 1024.f) + 1e-6f);
#pragma unroll
      for (int i = 0; i < 4; ++i) {
        bf16x4 o;
        o[0] = (short)f2bf(xv[4 * i] * rs * npq[i].x * (1.f + scq[i].x) + shq[i].x);
        o[1] = (short)f2bf(xv[4 * i + 1] * rs * npq[i].y * (1.f + scq[i].y) + shq[i].y);
        o[2] = (short)f2bf(xv[4 * i + 2] * rs * npq[i].z * (1.f + scq[i].z) + shq[i].z);
        o[3] = (short)f2bf(xv[4 * i + 3] * rs * npq[i].w * (1.f + scq[i].w) + shq[i].w);
        *(bf16x4*)(H + (size_t)g * D + i * 256 + lane * 4) = o;
      }
    }
  }
}

struct GA {
  const bf16* A; const bf16* A2; int lda; int ksplit;
  const float* mu;
  const bf16* Wt; int K; int N;
  bf16* o0; bf16* o1; int ldc; int act;
  const float* f0;
};
enum { EPI_STORE = 0, EPI_SWIGLU = 1, EPI_EVENIN = 2, EPI_VMIX = 3, EPI_GMUL = 4 };

template <int EPI, int WN>
DI void gemm_epilogue(const Params& P, const GA& g, int m0, int n0, int wm, int wn, int l15, int Q, f32x4 (&acc)[4][WN]) {
  const int wc0 = n0 + wn * (16 * WN);
  if constexpr (EPI == EPI_STORE) {
#pragma unroll
    for (int mt = 0; mt < 4; ++mt) {
      const size_t row = m0 + wm * 64 + mt * 16 + l15;
#pragma unroll
      for (int nt = 0; nt < WN; ++nt) {
        const int col = wc0 + nt * 16 + 4 * Q;
        if (col < g.N) {
          bf16x4 o;
#pragma unroll
          for (int r = 0; r < 4; ++r) {
            float v = acc[mt][nt][r];
            if (g.act == 1) v = tanhf(v); else if (g.act == 2) v = sigmoidf(v);
            o[r] = (short)f2bf(v);
          }
          *(bf16x4*)(g.o0 + row * g.ldc + col) = o;
          if (g.o1) *(bf16x4*)(g.o1 + row * g.ldc + col) = o;
        }
      }
    }
  } else if constexpr (EPI == EPI_SWIGLU) {
#pragma unroll
    for (int mt = 0; mt < 4; ++mt) {
      const size_t row = m0 + wm * 64 + mt * 16 + l15;
#pragma unroll
      for (int pr = 0; pr < WN / 2; ++pr) {
        const int jcol = (wc0 >> 1) + pr * 16 + 4 * Q;
        bf16x4 o;
#pragma unroll
        for (int r = 0; r < 4; ++r) {
          const float gt = acc[mt][2 * pr][r];
          o[r] = (short)f2bf(gt * __builtin_amdgcn_rcpf(1.f + __expf(-gt)) * acc[mt][2 * pr + 1][r]);
        }
        *(bf16x4*)(g.o0 + row * FH + jcol) = o;
      }
    }
  } else if constexpr (EPI == EPI_EVENIN) {
    bf16* Qb = (bf16*)(WSP + OFF_BIG);
    bf16* Kb = Qb + (size_t)M * D;
    bf16* Vt = Kb + (size_t)M * D;
    bf16* Zb = Vt + (size_t)M * D;
    bf16* BCb = Zb + (size_t)M * D;
    bf16* XS = (bf16*)(WSP + OFF_Y);
    float* DT = (float*)(WSP + OFF_DT);
    if (n0 < 2048) {
      const bool isq = n0 < 1024;
      bf16* dst = isq ? Qb : Kb;
      const float sc = isq ? 0.125f * 1.4426950408889634f : 1.f;
      const float* cosT = (const float*)(WSP + OFF_ROPE);
      const float* sinT = cosT + 2048;
#pragma unroll
      for (int vs = 0; vs < WN / 4; ++vs) {
        const int cb = (isq ? wc0 : wc0 - 1024) + vs * 64 + l15;
#pragma unroll
        for (int mt = 0; mt < 4; ++mt)
#pragma unroll
          for (int r = 0; r < 4; ++r) {
            const int row = m0 + wm * 64 + mt * 16 + 4 * Q + r;
            const int p = row % TB;
            float x1 = acc[mt][4 * vs + 0][r], x2 = acc[mt][4 * vs + 1][r], x3 = acc[mt][4 * vs + 2][r], x4 = acc[mt][4 * vs + 3][r];
            if (p >= CL) {
              const int t = p - CL, pr = t >> 6, pc = t & 63;
              const float cr = cosT[pr * 16 + l15], sr = sinT[pr * 16 + l15], c2 = cosT[pc * 16 + l15], s2 = sinT[pc * 16 + l15];
              const float o1 = x1 * cr - x2 * sr, o2 = x2 * cr + x1 * sr, o3 = x3 * c2 - x4 * s2, o4 = x4 * c2 + x3 * s2;
              x1 = o1; x2 = o2; x3 = o3; x4 = o4;
            }
            bf16* d = dst + (size_t)row * D + cb;
            d[0] = f2bf(x1 * sc); d[16] = f2bf(x2 * sc); d[32] = f2bf(x3 * sc); d[48] = f2bf(x4 * sc);
          }
      }
    } else if (n0 < 3072) {
      const int b = m0 / TB, pb = m0 - b * TB;
#pragma unroll
      for (int mt = 0; mt < 4; ++mt)
#pragma unroll
        for (int nt = 0; nt < WN; ++nt) {
          const int c = wc0 - 2048 + nt * 16 + l15;
          const int p0 = pb + wm * 64 + mt * 16 + 4 * Q;
          bf16x4 o;
#pragma unroll
          for (int r = 0; r < 4; ++r) o[r] = (short)f2bf(acc[mt][nt][r]);
          *(bf16x4*)(Vt + ((size_t)(b * 1024 + c)) * TB + p0) = o;
        }
    } else if (n0 < 5632) {
      bf16* dst; int ld, cb;
      if (n0 < 4096) { dst = Zb; ld = 1024; cb = wc0 - 3072; }
      else if (n0 < 5120) { dst = XS; ld = 1024; cb = wc0 - 4096; }
      else { dst = BCb; ld = 512; cb = wc0 - 5120; }
#pragma unroll
      for (int mt = 0; mt < 4; ++mt)
#pragma unroll
        for (int nt = 0; nt < WN; ++nt)
#pragma unroll
          for (int r = 0; r < 4; ++r) {
            const size_t row = m0 + wm * 64 + mt * 16 + 4 * Q + r;
            dst[row * ld + cb + nt * 16 + l15] = f2bf(acc[mt][nt][r]);
          }
    } else {
#pragma unroll
      for (int mt = 0; mt < 4; ++mt)
#pragma unroll
        for (int nt = 0; nt < WN; ++nt) {
          const int col = wc0 - 5632 + nt * 16 + l15;
          if (col < 32) {
#pragma unroll
            for (int r = 0; r < 4; ++r) {
              const size_t row = m0 + wm * 64 + mt * 16 + 4 * Q + r;
              DT[row * 32 + col] = acc[mt][nt][r];
            }
          }
        }
    }
  } else if constexpr (EPI == EPI_VMIX) {
    const bf16* VF = (const bf16*)(WSP + OFF_VF);
#pragma unroll
    for (int mt = 0; mt < 4; ++mt) {
      const size_t rb = (size_t)(m0 + wm * 64 + mt * 16 + l15) * D + wc0 + 4 * Q;
      bf16x4 ov[WN], of[WN];
      float4 v0[WN];
#pragma unroll
      for (int nt = 0; nt < WN; ++nt) {
        ov[nt] = *(const bf16x4*)(g.o0 + rb + nt * 16);
        of[nt] = *(const bf16x4*)(VF + rb + nt * 16);
        v0[nt] = *(const float4*)(g.f0 + wc0 + nt * 16 + 4 * Q);
      }
#pragma unroll
      for (int nt = 0; nt < WN; ++nt) {
        const float vz[4] = {v0[nt].x, v0[nt].y, v0[nt].z, v0[nt].w};
        bf16x4 o;
#pragma unroll
        for (int r = 0; r < 4; ++r) {
          const float v = bf2f((bf16)ov[nt][r]), vf = bf2f((bf16)of[nt][r]);
          o[r] = (short)f2bf(v + (vf - v) * sigmoidf(vz[r] + acc[mt][nt][r]));
        }
        *(bf16x4*)(g.o0 + rb + nt * 16) = o;
      }
    }
  } else if constexpr (EPI == EPI_GMUL) {
#pragma unroll
    for (int mt = 0; mt < 4; ++mt) {
      const size_t rb = (size_t)(m0 + wm * 64 + mt * 16 + l15) * D + wc0 + 4 * Q;
      bf16x4 ov[WN];
#pragma unroll
      for (int nt = 0; nt < WN; ++nt) ov[nt] = *(const bf16x4*)(g.o0 + rb + nt * 16);
#pragma unroll
      for (int nt = 0; nt < WN; ++nt) {
        bf16x4 o;
#pragma unroll
        for (int r = 0; r < 4; ++r) o[r] = (short)f2bf(bf2f((bf16)ov[nt][r]) * acc[mt][nt][r]);
        *(bf16x4*)(g.o0 + rb + nt * 16) = o;
      }
    }
  }
}

template <int BK, int AMODE, int EPI, int WN>
DI void gemm_phase(const Params& P, const GA& g, char* smem) {
  constexpr int LS = BK;
  constexpr int CPR = BK / 8;
  constexpr int BN = 32 * WN;
  constexpr int NCHA = 128 * CPR / 256, NCHB = BN * CPR / 256;
  constexpr int RSTEP = 256 / CPR;
  constexpr int BUF = (128 + BN) * LS;
  constexpr int GW = 8;
#define SWZ(row, c) ((BK == 64) ? ((c) ^ (((row) >> 1) & 7)) : ((c) ^ ((4 - (((row) >> 2) & 3)) & 3)))
  bf16* S0 = (bf16*)smem;
  const int tid = ltid(), lane = tid & 63, wave = tid >> 6, wm = wave >> 1, wn = wave & 1, l15 = lane & 15, Q = lane >> 4;
  const int ntn = (g.N + BN - 1) / BN, ntiles = (M / 128) * ntn;
  const int nk = g.K / BK;
  const int crow = tid / CPR, ckc = tid - crow * CPR;
  int tile_first = lbid();
  if constexpr (AMODE == 1) {
    tile_first = (tile_first - g.ksplit) % (int)gridDim.x;
    if (tile_first < 0) tile_first += (int)gridDim.x;
  }
  for (int tile = tile_first; tile < ntiles; tile += gridDim.x) {
    int tmi, tni;
    {
      const int x = tile & 7, i = tile >> 3, nfull = ntn / GW, rem = ntn - nfull * GW;
      if (i < nfull * (33 * GW)) { const int g8 = i / (33 * GW), ii = i - g8 * (33 * GW); tni = g8 * GW + (ii % GW); tmi = x * 33 + ii / GW; }
      else { const int ii = i - nfull * (33 * GW); tni = nfull * GW + ii % rem; tmi = x * 33 + ii / rem; }
    }
    const int m0 = tmi * 128, n0 = tni * BN;
    f32x4 acc[4][WN];
#pragma unroll
    for (int i = 0; i < 4; ++i)
#pragma unroll
      for (int j = 0; j < WN; ++j) acc[i][j] = f32x4{0.f, 0.f, 0.f, 0.f};
    struct RS { bf16x8 ra[NCHA], rb[NCHB], rp[AMODE ? NCHA : 1], rn[AMODE ? NCHA : 1]; float muv[AMODE ? 8 : 1]; };
    RS s0, s1;
    auto load_tiles = [&](RS& s, int kt) {
      const int k = kt * BK + ckc * 8;
#pragma unroll
      for (int i = 0; i < NCHA; ++i) {
        const int row = crow + i * RSTEP;
        const size_t gi = (size_t)(m0 + row);
        if constexpr (AMODE == 0) {
          const bf16* src = (g.A2 != nullptr && k >= g.ksplit) ? g.A2 + gi * g.lda + (k - g.ksplit) : g.A + gi * g.lda + k;
          s.ra[i] = *(const bf16x8*)src;
        } else {
          const int p = (int)(gi % TB);
          const bool hp = (p != 0) && (p != CL), hn = (p != CL - 1) && (p != TB - 1);
          const bf16* src = g.A + gi * g.lda + k;
          s.ra[i] = *(const bf16x8*)src;
          s.rp[i] = hp ? *(const bf16x8*)(src - g.lda) : bf16x8{0, 0, 0, 0, 0, 0, 0, 0};
          s.rn[i] = hn ? *(const bf16x8*)(src + g.lda) : bf16x8{0, 0, 0, 0, 0, 0, 0, 0};
        }
      }
#pragma unroll
      for (int i = 0; i < NCHB; ++i) {
        const int n = n0 + crow + i * RSTEP;
        if (n < g.N) s.rb[i] = *(const bf16x8*)(g.Wt + (size_t)n * g.K + k);
        else s.rb[i] = bf16x8{0, 0, 0, 0, 0, 0, 0, 0};
      }
      if constexpr (AMODE == 1) {
        const float4 m0v = *(const float4*)(g.mu + k), m1v = *(const float4*)(g.mu + k + 4);
        s.muv[0] = m0v.x; s.muv[1] = m0v.y; s.muv[2] = m0v.z; s.muv[3] = m0v.w; s.muv[4] = m1v.x; s.muv[5] = m1v.y; s.muv[6] = m1v.z; s.muv[7] = m1v.w;
      }
    };
    auto store_tiles = [&](const RS& s, int buf) {
      bf16* As = S0 + buf * BUF;
      bf16* Bs = As + 128 * LS;
#pragma unroll
      for (int i = 0; i < NCHA; ++i) {
        const int row = crow + i * RSTEP;
        if constexpr (AMODE == 0) {
          *(bf16x8*)(As + row * LS + SWZ(row, ckc) * 8) = s.ra[i];
        } else {
          bf16x8 o;
#pragma unroll
          for (int e = 0; e < 8; ++e) {
            const float hv = bf2f((bf16)s.ra[i][e]);
            const float pv = bf2f((bf16)s.rp[i][e]), nv = bf2f((bf16)s.rn[i][e]);
            o[e] = (short)f2bf(hv + (0.5f * (pv + nv) - hv) * s.muv[e]);
          }
          *(bf16x8*)(As + row * LS + SWZ(row, ckc) * 8) = o;
        }
      }
#pragma unroll
      for (int i = 0; i < NCHB; ++i) *(bf16x8*)(Bs + (crow + i * RSTEP) * LS + SWZ(crow + i * RSTEP, ckc) * 8) = s.rb[i];
    };
    auto compute = [&](int buf) {
      __builtin_amdgcn_s_setprio(1);
      const bf16* As = S0 + buf * BUF;
      const bf16* Bs = As + 128 * LS;
#pragma unroll
      for (int ks = 0; ks < BK / 32; ++ks) {
        bf16x8 af[4], bfr[WN];
#pragma unroll
        for (int t = 0; t < 4; ++t) af[t] = *(const bf16x8*)(As + (wm * 64 + t * 16 + l15) * LS + SWZ(l15, ks * 4 + Q) * 8);
#pragma unroll
        for (int t = 0; t < WN; ++t) bfr[t] = *(const bf16x8*)(Bs + (wn * (16 * WN) + t * 16 + l15) * LS + SWZ(l15, ks * 4 + Q) * 8);
#pragma unroll
        for (int mt = 0; mt < 4; ++mt)
#pragma unroll
          for (int nt = 0; nt < WN; ++nt) {
            if constexpr (EPI != EPI_EVENIN) acc[mt][nt] = MFMA16(bfr[nt], af[mt], acc[mt][nt]);
            else acc[mt][nt] = MFMA16(af[mt], bfr[nt], acc[mt][nt]);
          }
      }
      __builtin_amdgcn_s_setprio(0);
    };
    __syncthreads();
    load_tiles(s0, 0);
    store_tiles(s0, 0);
    if constexpr (AMODE == 0 && WN == 4) {
      if (nk > 1) load_tiles(s0, 1);
      __syncthreads();
      for (int kt = 0; kt < nk; kt += 2) {
        if (kt + 2 < nk) load_tiles(s1, kt + 2);
        compute(0);
        if (kt + 1 < nk) store_tiles(s0, 1);
        __syncthreads();
        if (kt + 1 < nk) {
          if (kt + 3 < nk) load_tiles(s0, kt + 3);
          compute(1);
          if (kt + 2 < nk) store_tiles(s1, 0);
          __syncthreads();
        }
      }
    } else {
      __syncthreads();
      for (int kt = 0; kt < nk; ++kt) {
        if (kt + 1 < nk) load_tiles(s0, kt + 1);
        compute(kt & 1);
        if (kt + 1 < nk) store_tiles(s0, (kt + 1) & 1);
        __syncthreads();
      }
    }
    gemm_epilogue<EPI, WN>(P, g, m0, n0, wm, wn, l15, Q, acc);
  }
}

DI GA make_ga(const bf16* A, int lda, const bf16* Wt, int K, int N, bf16* o0, int ldc) {
  GA g; g.A = A; g.A2 = nullptr; g.lda = lda; g.ksplit = 0; g.mu = nullptr; g.Wt = Wt; g.K = K; g.N = N; g.o0 = o0; g.o1 = nullptr; g.ldc = ldc; g.act = 0; g.f0 = nullptr;
  return g;
}

DI void phase_attn(const Params& P, int j, int layer, char* smem, bool dry) {
  bf16* Qb = (bf16*)(WSP + OFF_BIG);
  const bf16* Kb = Qb + (size_t)M * D;
  const bf16* Vt = Kb + (size_t)M * D;
  constexpr int KBYTES = 64 * 272, VBYTES = 128 * 144, STAGE = KBYTES + VBYTES;
  const int tid = ltid(), lane = tid & 63, wave = tid >> 6, l15 = lane & 15, Q = lane >> 4;
  const float lam_init = 0.8f - 0.6f * expf(-0.3f * (float)layer);
  float lam;
  {
    const float* lp = IN(I_LAMBDA) + j * 256;
    float s1 = 0.f, s2 = 0.f;
    for (int i = 0; i < 64; ++i) { s1 += lp[i] * lp[64 + i]; s2 += lp[128 + i] * lp[192 + i]; }
    lam = expf(s1) - expf(s2) + lam_init;
  }
  const float* subln = IN(I_SUBLN) + j * 128;
  const int nitems = 2048 + 64;
  const int krow = tid >> 4, kc16 = tid & 15, vrow = tid >> 3, vc = tid & 7;
  for (int item = lbid(); item < nitems; item += gridDim.x) {
    int b, h, q0, nkv;
    if (item < 2048) {
      const int x = item & 7, i = item >> 3, pair = x * 4 + (i >> 6);
      b = pair >> 3; h = pair & 7; q0 = CL + (i & 63) * 128; nkv = 132;
    } else { const int it = item - 2048; b = it >> 4; h = (it >> 1) & 7; q0 = (it & 1) * 128; nkv = 4; }
    const size_t gb = (size_t)b * TB;
    const bf16* Kbase = Kb + gb * D + h * 128 + kc16 * 8;
    const bf16* Vbase = Vt + ((size_t)(b * 1024 + h * 128)) * TB + vc * 8;
    bf16x8 Qf[2][2][2];
#pragma unroll
    for (int qt = 0; qt < 2; ++qt)
#pragma unroll
      for (int m = 0; m < 2; ++m)
#pragma unroll
        for (int ks = 0; ks < 2; ++ks)
          Qf[qt][m][ks] = *(const bf16x8*)(Qb + (gb + q0 + wave * 32 + qt * 16 + l15) * D + h * 128 + m * 64 + ks * 32 + Q * 8);
    float mrun[2][2], lrun[2][2];
#pragma unroll
    for (int qt = 0; qt < 2; ++qt)
#pragma unroll
      for (int m = 0; m < 2; ++m) { mrun[qt][m] = 0.f; lrun[qt][m] = 0.f; }
    bf16x8 pk[4], pv[4];
    __syncthreads();
#pragma unroll
    for (int i = 0; i < 4; ++i) pk[i] = *(const bf16x8*)(Kbase + (size_t)(krow + 16 * i) * D);
#pragma unroll
    for (int i = 0; i < 4; ++i) *(bf16x8*)(smem + (krow + 16 * i) * 272 + kc16 * 16) = pk[i];
    __syncthreads();
#pragma unroll
    for (int m = 0; m < 2; ++m) {
      float mx0 = -3.0e38f, mx1 = -3.0e38f;
#pragma unroll
      for (int kt = 0; kt < 4; ++kt) {
        const bf16x8 k0 = *(const bf16x8*)(smem + (kt * 16 + l15) * 272 + (m * 64 + Q * 8) * 2);
        const bf16x8 k1 = *(const bf16x8*)(smem + (kt * 16 + l15) * 272 + (m * 64 + 32 + Q * 8) * 2);
        f32x4 t0 = f32x4{0.f, 0.f, 0.f, 0.f}, t1 = f32x4{0.f, 0.f, 0.f, 0.f};
        t0 = MFMA16(k0, Qf[0][m][0], t0); t0 = MFMA16(k1, Qf[0][m][1], t0);
        t1 = MFMA16(k0, Qf[1][m][0], t1); t1 = MFMA16(k1, Qf[1][m][1], t1);
        mx0 = fmaxf(fmaxf(mx0, fmaxf(t0[0], t0[1])), fmaxf(t0[2], t0[3]));
        mx1 = fmaxf(fmaxf(mx1, fmaxf(t1[0], t1[1])), fmaxf(t1[2], t1[3]));
      }
      mrun[0][m] = mx0 + 32.f; mrun[1][m] = mx1 + 32.f;
    }
    for (int kv = 0; kv < nkv; ++kv) {
      if (kv + 1 < nkv) {
#pragma unroll
        for (int i = 0; i < 4; ++i) pk[i] = *(const bf16x8*)(Kbase + (size_t)((kv + 1) * 64 + krow + 16 * i) * D);
      }
      const char* sK = smem + (kv & 1) * STAGE;
#pragma unroll
      for (int m = 0; m < 2; ++m) {
#pragma unroll
        for (int kt = 0; kt < 4; ++kt) {
          const bf16x8 k0 = *(const bf16x8*)(sK + (kt * 16 + l15) * 272 + (m * 64 + Q * 8) * 2);
          const bf16x8 k1 = *(const bf16x8*)(sK + (kt * 16 + l15) * 272 + (m * 64 + 32 + Q * 8) * 2);
#pragma unroll
          for (int qt = 0; qt < 2; ++qt) {
            const float nb = -mrun[qt][m];
            f32x4 t = f32x4{nb, nb, nb, nb};
            t = MFMA16(k0, Qf[qt][m][0], t);
            t = MFMA16(k1, Qf[qt][m][1], t);
            lrun[qt][m] += (__builtin_amdgcn_exp2f(t[0]) + __builtin_amdgcn_exp2f(t[1])) + (__builtin_amdgcn_exp2f(t[2]) + __builtin_amdgcn_exp2f(t[3]));
          }
        }
      }
      if (kv + 1 < nkv) {
        char* dK = smem + ((kv + 1) & 1) * STAGE;
#pragma unroll
        for (int i = 0; i < 4; ++i) *(bf16x8*)(dK + (krow + 16 * i) * 272 + kc16 * 16) = pk[i];
      }
      __syncthreads();
    }
    float Mx[2][2];
#pragma unroll
    for (int qt = 0; qt < 2; ++qt)
#pragma unroll
      for (int m = 0; m < 2; ++m) {
        float mm = mrun[qt][m], ll = lrun[qt][m];
#pragma unroll
        for (int o = 16; o <= 32; o <<= 1) {
          const float mo = __shfl_xor(mm, o), lo = __shfl_xor(ll, o);
          const float mn = fmaxf(mm, mo);
          ll = ll * __builtin_amdgcn_exp2f(mm - mn) + lo * __builtin_amdgcn_exp2f(mo - mn);
          mm = mn;
        }
        Mx[qt][m] = mm + __log2f(ll);
      }
    f32x4 O[2][8];
#pragma unroll
    for (int qt = 0; qt < 2; ++qt)
#pragma unroll
      for (int t = 0; t < 8; ++t) O[qt][t] = f32x4{0.f, 0.f, 0.f, 0.f};
#pragma unroll
    for (int i = 0; i < 4; ++i) {
      pk[i] = *(const bf16x8*)(Kbase + (size_t)(krow + 16 * i) * D);
      pv[i] = *(const bf16x8*)(Vbase + (size_t)(vrow + 32 * i) * TB);
    }
#pragma unroll
    for (int i = 0; i < 4; ++i) {
      *(bf16x8*)(smem + (krow + 16 * i) * 272 + kc16 * 16) = pk[i];
      *(bf16x8*)(smem + KBYTES + (vrow + 32 * i) * 144 + vc * 16) = pv[i];
    }
    __syncthreads();
    for (int kv = 0; kv < nkv; ++kv) {
      if (kv + 1 < nkv) {
#pragma unroll
        for (int i = 0; i < 4; ++i) {
          pk[i] = *(const bf16x8*)(Kbase + (size_t)((kv + 1) * 64 + krow + 16 * i) * D);
          pv[i] = *(const bf16x8*)(Vbase + (size_t)(vrow + 32 * i) * TB + (kv + 1) * 64);
        }
      }
      const char* sK = smem + (kv & 1) * STAGE;
      const char* sV = sK + KBYTES;
#pragma unroll
      for (int ks2 = 0; ks2 < 2; ++ks2) {
        bf16x8 Pf[2];
#pragma unroll
        for (int half = 0; half < 2; ++half) {
          const int kt = ks2 * 2 + half;
          f32x4 s[2][2];
#pragma unroll
          for (int m = 0; m < 2; ++m) {
            const bf16x8 k0 = *(const bf16x8*)(sK + (kt * 16 + l15) * 272 + (m * 64 + Q * 8) * 2);
            const bf16x8 k1 = *(const bf16x8*)(sK + (kt * 16 + l15) * 272 + (m * 64 + 32 + Q * 8) * 2);
#pragma unroll
            for (int qt = 0; qt < 2; ++qt) {
              const float nm = -Mx[qt][m];
              f32x4 t = f32x4{nm, nm, nm, nm};
              t = MFMA16(k0, Qf[qt][m][0], t);
              t = MFMA16(k1, Qf[qt][m][1], t);
              s[qt][m] = t;
            }
          }
#pragma unroll
          for (int qt = 0; qt < 2; ++qt)
#pragma unroll
            for (int r = 0; r < 4; ++r) {
              const float a = __builtin_amdgcn_exp2f(s[qt][0][r]) - lam * __builtin_amdgcn_exp2f(s[qt][1][r]);
              Pf[qt][half * 4 + r] = (short)f2bf(a);
            }
        }
        __builtin_amdgcn_s_setprio(1);
#pragma unroll
        for (int t = 0; t < 8; ++t) {
          const bf16x4 v0 = *(const bf16x4*)(sV + (t * 16 + l15) * 144 + (ks2 * 32 + Q * 4) * 2);
          const bf16x4 v1 = *(const bf16x4*)(sV + (t * 16 + l15) * 144 + (ks2 * 32 + 16 + Q * 4) * 2);
          const bf16x8 vf = __builtin_shufflevector(v0, v1, 0, 1, 2, 3, 4, 5, 6, 7);
#pragma unroll
          for (int qt = 0; qt < 2; ++qt) O[qt][t] = MFMA16(vf, Pf[qt], O[qt][t]);
        }
        __builtin_amdgcn_s_setprio(0);
      }
      if (kv + 1 < nkv) {
        char* dK = smem + ((kv + 1) & 1) * STAGE;
#pragma unroll
        for (int i = 0; i < 4; ++i) {
          *(bf16x8*)(dK + (krow + 16 * i) * 272 + kc16 * 16) = pk[i];
          *(bf16x8*)(dK + KBYTES + (vrow + 32 * i) * 144 + vc * 16) = pv[i];
        }
      }
      __syncthreads();
    }
    if (!dry) {
      float4 swv[8];
#pragma unroll
      for (int t = 0; t < 8; ++t) swv[t] = *(const float4*)(subln + t * 16 + Q * 4);
#pragma unroll
      for (int qt = 0; qt < 2; ++qt) {
        float ss = 0.f;
#pragma unroll
        for (int t = 0; t < 8; ++t)
#pragma unroll
          for (int r = 0; r < 4; ++r) ss += O[qt][t][r] * O[qt][t][r];
        ss += __shfl_xor(ss, 16);
        ss += __shfl_xor(ss, 32);
        const float rs = rsqrtf(ss * (1.f / 128.f) + 1e-5f) * (1.f - lam_init);
        bf16* dst = Qb + (gb + q0 + wave * 32 + qt * 16 + l15) * D + h * 128;
#pragma unroll
        for (int t = 0; t < 8; ++t) {
          const float4 sw = swv[t];
          bf16x4 o;
          o[0] = (short)f2bf(O[qt][t][0] * rs * sw.x); o[1] = (short)f2bf(O[qt][t][1] * rs * sw.y);
          o[2] = (short)f2bf(O[qt][t][2] * rs * sw.z); o[3] = (short)f2bf(O[qt][t][3] * rs * sw.w);
          *(bf16x4*)(dst + t * 16 + Q * 4) = o;
        }
      }
    }
  }
}

DI void phase_ssd_scan(const Params& P, int j, char* smem, int cu_idx, int nact) {
  float* sX = (float*)smem;
  float* sB = sX + 32 * 64;
  float* sC = sB + 32 * 128;
  float* sDt = sC + 32 * 128;
  float* sDA = sDt + 32;
  float* sY = sDA + 32;
  bf16* sRaw = (bf16*)(sY + 1024);
  const bf16* XS = (const bf16*)(WSP + OFF_Y);
  const bf16* BCb = (const bf16*)(WSP + OFF_BIG) + (size_t)4 * M * D;
  const float* DT = (const float*)(WSP + OFF_DT);
  bf16* Y0 = (bf16*)(WSP + OFF_H);
  bf16* Y1 = (bf16*)(WSP + OFF_BIG) + (size_t)M * D;
  const int tid = ltid(), prow = tid >> 3, nq = tid & 7;
  if (cu_idx < 0) return;
  for (int item = cu_idx; item < 256; item += nact) {
    const int chain = item >> 1, sp = item & 1;
    const int b = chain >> 5, dir = (chain >> 4) & 1, head = chain & 15, grp = head >> 3;
    const size_t gb = (size_t)b * TB;
    const float a_h = -expf(IN(I_ALOG)[(j * 2 + dir) * 16 + head]);
    const float dbias = IN(I_DTBIAS)[(j * 2 + dir) * 16 + head];
    const float dskip = dir == 0 ? IN(I_SSDD)[j * 16 + head] : 0.f;
    bf16* Yd = dir == 0 ? Y0 : Y1;
    const int myp = sp * 32 + prow;
    const int step = dir == 0 ? 1 : -1;
    float hst[16];
#pragma unroll
    for (int e = 0; e < 16; ++e) hst[e] = 0.f;
    bf16x8 pre[6];
    float predt = 0.f;
    auto issue = [&](int s0n) {
      const bool isctx = s0n < CL;
      const int pfirst = dir == 0 ? s0n : (isctx ? 255 - s0n : 8703 - s0n);
      const int seg_lo = isctx ? 0 : CL, seg_hi = isctx ? CL : TB;
      const int plo = dir == 0 ? pfirst : pfirst - 31;
#pragma unroll
      for (int r = 0; r < 6; ++r) {
        const int id = tid + 256 * r;
        pre[r] = bf16x8{0, 0, 0, 0, 0, 0, 0, 0};
        if (id < 1440) {
          const int rr = id / 40, cc = id - rr * 40;
          const int q = plo - 2 + rr;
          if (q >= seg_lo && q < seg_hi) {
            const bf16* src = cc < 8 ? XS + (gb + q) * 1024 + head * 64 + cc * 8
                                     : (cc < 24 ? BCb + (gb + q) * 512 + grp * 128 + (cc - 8) * 8 : BCb + (gb + q) * 512 + 256 + grp * 128 + (cc - 24) * 8);
            pre[r] = *(const bf16x8*)src;
          }
        }
      }
      if (tid < 32) predt = DT[(gb + pfirst + tid * step) * 32 + dir * 16 + head];
    };
    issue(0);
    for (int s0 = 0; s0 < TB; s0 += 32) {
      const bool isctx = s0 < CL;
      const int pfirst = dir == 0 ? s0 : (isctx ? 255 - s0 : 8703 - s0);
#pragma unroll
      for (int r = 0; r < 6; ++r) {
        const int id = tid + 256 * r;
        if (id < 1440) { const int rr = id / 40, cc = id - rr * 40; *(bf16x8*)(sRaw + rr * 328 + cc * 8) = pre[r]; }
      }
      if (tid < 32) { const float dt = softplusf(predt + dbias); sDt[tid] = dt; sDA[tid] = __expf(dt * a_h); }
      __syncthreads();
      if (s0 + 32 < TB) issue(s0 + 32);
      for (int u = tid; u < 640; u += 256) {
        const int c = u % 320, hf = u / 320;
        int ch; float* dstp; int dld;
        if (c < 64) { ch = head * 64 + c; dstp = sX + c; dld = 64; }
        else if (c < 192) { const int n = c - 64; ch = 1024 + grp * 128 + n; dstp = sB + n; dld = 128; }
        else { const int n = c - 192; ch = 1280 + grp * 128 + n; dstp = sC + n; dld = 128; }
        float raw[20];
#pragma unroll
        for (int i = 0; i < 20; ++i) raw[i] = bf2f(sRaw[(hf * 16 + i) * 328 + c]);
        const float* cw = IN(I_CONVW) + (size_t)j * 5 * 1536 + ch;
        const float w0 = cw[0], w1 = cw[1536], w2 = cw[2 * 1536], w3 = cw[3 * 1536], w4 = cw[4 * 1536];
        const float cbias = IN(I_CONVB)[j * 1536 + ch];
#pragma unroll
        for (int ii = 0; ii < 16; ++ii) {
          float v = cbias + w0 * raw[ii] + w1 * raw[ii + 1] + w2 * raw[ii + 2] + w3 * raw[ii + 3] + w4 * raw[ii + 4];
          v = v * __builtin_amdgcn_rcpf(1.f + __expf(-v));
          const int nl = hf * 16 + ii;
          const int li = dir == 0 ? nl : 31 - nl;
          dstp[li * dld] = v;
        }
      }
      __syncthreads();
      float4 bq[4], cq[4];
#pragma unroll
      for (int e = 0; e < 4; ++e) { bq[e] = *(const float4*)(sB + nq * 16 + e * 4); cq[e] = *(const float4*)(sC + nq * 16 + e * 4); }
      float xv = sX[myp], dt = sDt[0], dA = sDA[0];
#pragma unroll 2
      for (int i = 0; i < 32; ++i) {
        const int in = i < 31 ? i + 1 : 31;
        float4 nb[4], nc[4];
#pragma unroll
        for (int e = 0; e < 4; ++e) { nb[e] = *(const float4*)(sB + in * 128 + nq * 16 + e * 4); nc[e] = *(const float4*)(sC + in * 128 + nq * 16 + e * 4); }
        const float nxv = sX[in * 64 + myp], ndt = sDt[in], ndA = sDA[in];
        const float xdt = xv * dt;
        float pp[4];
#pragma unroll
        for (int e = 0; e < 4; ++e) {
          hst[4 * e + 0] = dA * hst[4 * e + 0] + xdt * bq[e].x; hst[4 * e + 1] = dA * hst[4 * e + 1] + xdt * bq[e].y;
          hst[4 * e + 2] = dA * hst[4 * e + 2] + xdt * bq[e].z; hst[4 * e + 3] = dA * hst[4 * e + 3] + xdt * bq[e].w;
          pp[e] = (cq[e].x * hst[4 * e + 0] + cq[e].y * hst[4 * e + 1]) + (cq[e].z * hst[4 * e + 2] + cq[e].w * hst[4 * e + 3]);
        }
        float part = (pp[0] + pp[1]) + (pp[2] + pp[3]);
        part = red8(part);
        if (nq == 0) sY[i * 32 + prow] = part + dskip * xv;
#pragma unroll
        for (int e = 0; e < 4; ++e) { bq[e] = nb[e]; cq[e] = nc[e]; }
        xv = nxv; dt = ndt; dA = ndA;
      }
      __syncthreads();
      {
        const int i = tid >> 3, r4 = (tid & 7) * 4;
        const int p = pfirst + i * step;
        bf16x4 o;
        o[0] = (short)f2bf(sY[i * 32 + r4]); o[1] = (short)f2bf(sY[i * 32 + r4 + 1]); o[2] = (short)f2bf(sY[i * 32 + r4 + 2]); o[3] = (short)f2bf(sY[i * 32 + r4 + 3]);
        *(bf16x4*)(Yd + (gb + p) * D + head * 64 + sp * 32 + r4) = o;
      }
    }
    __syncthreads();
  }
}

DI void phase_bcconv(const Params& P, int j) {
  const int lane = ltid() & 63;
  const int gw = lbid() * 4 + (ltid() >> 6), nw = gridDim.x * 4;
  const bf16* BCb = (const bf16*)(WSP + OFF_BIG) + (size_t)4 * M * D;
  bf16* BCc = (bf16*)(WSP + OFF_BIG) + (size_t)2 * M * D;
  const float* cw = IN(I_CONVW) + (size_t)j * 5 * 1536 + 1024 + lane * 8;
  const float* cb = IN(I_CONVB) + j * 1536 + 1024 + lane * 8;
  float w[5][8], bias[8];
#pragma unroll
  for (int t = 0; t < 5; ++t)
#pragma unroll
    for (int e = 0; e < 8; ++e) w[t][e] = cw[t * 1536 + e];
#pragma unroll
  for (int e = 0; e < 8; ++e) bias[e] = cb[e];
  for (int run = gw; run < M / 16; run += nw) {
    const int g0 = run * 16, b = g0 / TB, p0 = g0 - b * TB;
    const int seg_lo = p0 < CL ? 0 : CL, seg_hi = p0 < CL ? CL : TB;
    bf16x8 win[5];
#pragma unroll
    for (int t = 0; t < 4; ++t) {
      const int q = p0 - 2 + t;
      win[t + 1] = (q >= seg_lo && q < seg_hi) ? *(const bf16x8*)(BCb + ((size_t)b * TB + q) * 512 + lane * 8) : bf16x8{0, 0, 0, 0, 0, 0, 0, 0};
    }
#pragma unroll 4
    for (int i = 0; i < 16; ++i) {
#pragma unroll
      for (int t = 0; t < 4; ++t) win[t] = win[t + 1];
      const int q = p0 + i + 2;
      win[4] = (q < seg_hi) ? *(const bf16x8*)(BCb + ((size_t)b * TB + q) * 512 + lane * 8) : bf16x8{0, 0, 0, 0, 0, 0, 0, 0};
      bf16x8 o;
#pragma unroll
      for (int e = 0; e < 8; ++e) {
        float v = bias[e];
#pragma unroll
        for (int t = 0; t < 5; ++t) v += w[t][e] * bf2f((bf16)win[t][e]);
        v = v * __builtin_amdgcn_rcpf(1.f + __expf(-v));
        o[e] = (short)f2bf(v);
      }
      *(bf16x8*)(BCc + ((size_t)g0 + i) * 512 + lane * 8) = o;
    }
  }
}

DI void phase_ssd_chunk(const Params& P, int j, char* smem, int cu_idx, int nact) {
  bf16* sB = (bf16*)smem;
  bf16* sC = sB + 32 * 136;
  bf16* sBt = sC + 32 * 136;
  bf16* sXd = sBt + 128 * 40;
  bf16* sGm = sXd + 64 * 40;
  bf16* sH = sGm + 32 * 40;
  bf16* sXr = sH + 64 * 136;
  float* sDt = (float*)(sXr + 36 * 72);
  float* sAcs = sDt + 32;
  float* sScl = sAcs + 32;
  const bf16* XS = (const bf16*)(WSP + OFF_Y);
  const bf16* BCc = (const bf16*)(WSP + OFF_BIG) + (size_t)2 * M * D;
  const float* DT = (const float*)(WSP + OFF_DT);
  bf16* Y0 = (bf16*)(WSP + OFF_H);
  bf16* Y1 = (bf16*)(WSP + OFF_BIG) + (size_t)M * D;
  const int tid = ltid(), lane = tid & 63, wave = tid >> 6, l15 = lane & 15, Q = lane >> 4;
  if (cu_idx < 0) return;
  for (int item = cu_idx; item < 128; item += nact) {
    const int b = item >> 5, dir = (item >> 4) & 1, head = item & 15, grp = head >> 3;
    const size_t gb = (size_t)b * TB;
    const float a_h = -expf(IN(I_ALOG)[(j * 2 + dir) * 16 + head]);
    const float dbias = IN(I_DTBIAS)[(j * 2 + dir) * 16 + head];
    const float dskip = dir == 0 ? IN(I_SSDD)[j * 16 + head] : 0.f;
    bf16* Yd = dir == 0 ? Y0 : Y1;
    const int step = dir == 0 ? 1 : -1;
    const int cch = tid & 63, cq = tid >> 6;
    const float* cwp = IN(I_CONVW) + (size_t)j * 5 * 1536 + head * 64 + cch;
    const float w0 = cwp[0], w1 = cwp[1536], w2 = cwp[2 * 1536], w3 = cwp[3 * 1536], w4 = cwp[4 * 1536];
    const float cbias = IN(I_CONVB)[j * 1536 + head * 64 + cch];
    __syncthreads();
    for (int i = tid; i < 64 * 136 / 8; i += 256) *(bf16x8*)(sH + i * 8) = bf16x8{0, 0, 0, 0, 0, 0, 0, 0};
    f32x4 hacc[8];
#pragma unroll
    for (int t = 0; t < 8; ++t) hacc[t] = f32x4{0.f, 0.f, 0.f, 0.f};
    struct PF { bf16x8 px[2], pbc[4]; float predt; };
    PF pfa, pfb;
    pfa.predt = 0.f; pfb.predt = 0.f;
    auto issue = [&](PF& pf, int s0n) {
      const bool isctx = s0n < CL;
      const int pfirst = dir == 0 ? s0n : (isctx ? 255 - s0n : 8703 - s0n);
      const int seg_lo = isctx ? 0 : CL, seg_hi = isctx ? CL : TB;
      const int plo = dir == 0 ? pfirst : pfirst - 31;
#pragma unroll
      for (int r = 0; r < 2; ++r) {
        const int id = tid + 256 * r;
        pf.px[r] = bf16x8{0, 0, 0, 0, 0, 0, 0, 0};
        if (id < 288) {
          const int rr = id >> 3, cc = id & 7, q = plo - 2 + rr;
          if (q >= seg_lo && q < seg_hi) pf.px[r] = *(const bf16x8*)(XS + (gb + q) * 1024 + head * 64 + cc * 8);
        }
      }
#pragma unroll
      for (int r = 0; r < 4; ++r) {
        const int id = tid + 256 * r, li = id >> 5, cc = id & 31;
        const size_t gi = gb + pfirst + li * step;
        pf.pbc[r] = *(const bf16x8*)(BCc + gi * 512 + (cc < 16 ? grp * 128 + cc * 8 : 256 + grp * 128 + (cc - 16) * 8));
      }
      if (tid < 32) pf.predt = DT[(gb + pfirst + tid * step) * 32 + dir * 16 + head];
    };
    issue(pfa, 0);
    issue(pfb, 32);
    auto chunk = [&](int s0, PF& pf) {
      const bool isctx = s0 < CL;
      const int pfirst = dir == 0 ? s0 : (isctx ? 255 - s0 : 8703 - s0);
#pragma unroll
      for (int r = 0; r < 2; ++r) {
        const int id = tid + 256 * r;
        if (id < 288) *(bf16x8*)(sXr + (id >> 3) * 72 + (id & 7) * 8) = pf.px[r];
      }
#pragma unroll
      for (int r = 0; r < 4; ++r) {
        const int id = tid + 256 * r, li = id >> 5, cc = id & 31;
        if (cc < 16) *(bf16x8*)(sB + li * 136 + cc * 8) = pf.pbc[r];
        else *(bf16x8*)(sC + li * 136 + (cc - 16) * 8) = pf.pbc[r];
      }
      if (wave == 0) {
        const float xx = pf.predt + dbias, ex = __expf(xx);
        const float dt = xx > 20.f ? xx : (ex < 0.01f ? ex * (1.f - ex * (0.5f - ex * 0.33333334f)) : __logf(1.f + ex));
        float v = dt * a_h;
        v += __int_as_float(__builtin_amdgcn_update_dpp(0, __float_as_int(v), 0x111, 0xf, 0xf, true));
        v += __int_as_float(__builtin_amdgcn_update_dpp(0, __float_as_int(v), 0x112, 0xf, 0xf, true));
        v += __int_as_float(__builtin_amdgcn_update_dpp(0, __float_as_int(v), 0x114, 0xf, 0xf, true));
        v += __int_as_float(__builtin_amdgcn_update_dpp(0, __float_as_int(v), 0x118, 0xf, 0xf, true));
        const float r0 = __int_as_float(__builtin_amdgcn_readlane(__float_as_int(v), 15));
        if (lane >= 16) v += r0;
        const float lastv = __int_as_float(__builtin_amdgcn_readlane(__float_as_int(v), 31));
        if (lane < 32) { sDt[lane] = dt; sAcs[lane] = v; sScl[lane] = __expf(lastv - v); }
      }
      __syncthreads();
      if (s0 + 64 < TB) issue(pf, s0 + 64);
      const float acs_last = sAcs[31];
      {
        float raw[12];
#pragma unroll
        for (int i = 0; i < 12; ++i) raw[i] = bf2f(sXr[(cq * 8 + i) * 72 + cch]);
#pragma unroll
        for (int ii = 0; ii < 8; ++ii) {
          float v = cbias + w0 * raw[ii] + w1 * raw[ii + 1] + w2 * raw[ii + 2] + w3 * raw[ii + 3] + w4 * raw[ii + 4];
          v = v * __builtin_amdgcn_rcpf(1.f + __expf(-v));
          const int nl = cq * 8 + ii, li = dir == 0 ? nl : 31 - nl;
          sXd[cch * 40 + li] = f2bf(v * sDt[li]);
        }
#pragma unroll
        for (int e = 0; e < 2; ++e) {
          const int idx = tid + 256 * e, li = idx & 31, n8 = idx >> 5;
          const bf16x8 bv = *(const bf16x8*)(sB + li * 136 + n8 * 8);
          const float sc = sScl[li];
#pragma unroll
          for (int k = 0; k < 8; ++k) sBt[(n8 * 8 + k) * 40 + li] = f2bf(bf2f((bf16)bv[k]) * sc);
        }
      }
      {
        const int jt = wave >> 1, it = wave & 1;
        f32x4 acc = f32x4{0.f, 0.f, 0.f, 0.f};
        if (jt <= it) {
#pragma unroll
          for (int ks = 0; ks < 4; ++ks)
            acc = MFMA16(*(const bf16x8*)(sB + (16 * jt + l15) * 136 + 32 * ks + 8 * Q), *(const bf16x8*)(sC + (16 * it + l15) * 136 + 32 * ks + 8 * Q), acc);
        }
        const int i = 16 * it + l15;
        const float ai = sAcs[i];
        bf16x4 o;
#pragma unroll
        for (int r = 0; r < 4; ++r) {
          const int jx = 16 * jt + 4 * Q + r;
          float gv = (jx <= i) ? acc[r] * __expf(ai - sAcs[jx]) : 0.f;
          if (jx == i) gv += dskip / sDt[i];
          o[r] = (short)f2bf(gv);
        }
        *(bf16x4*)(sGm + i * 40 + 16 * jt + 4 * Q) = o;
      }
      __syncthreads();
      {
        const bf16x8 ax = *(const bf16x8*)(sXd + (16 * wave + l15) * 40 + 8 * Q);
#pragma unroll
        for (int it = 0; it < 2; ++it) {
          f32x4 accd = f32x4{0.f, 0.f, 0.f, 0.f}, acco = f32x4{0.f, 0.f, 0.f, 0.f};
          accd = MFMA16(ax, *(const bf16x8*)(sGm + (16 * it + l15) * 40 + 8 * Q), accd);
#pragma unroll
          for (int ks = 0; ks < 4; ++ks)
            acco = MFMA16(*(const bf16x8*)(sH + (16 * wave + l15) * 136 + 32 * ks + 8 * Q), *(const bf16x8*)(sC + (16 * it + l15) * 136 + 32 * ks + 8 * Q), acco);
          const int i = 16 * it + l15;
          const float ev = __expf(sAcs[i]);
          bf16x4 o;
#pragma unroll
          for (int r = 0; r < 4; ++r) o[r] = (short)f2bf(accd[r] + ev * acco[r]);
          *(bf16x4*)(Yd + (gb + pfirst + i * step) * D + head * 64 + 16 * wave + 4 * Q) = o;
        }
        const float dec = __expf(acs_last);
#pragma unroll
        for (int nt = 0; nt < 8; ++nt) {
          hacc[nt] = hacc[nt] * dec;
          hacc[nt] = MFMA16(*(const bf16x8*)(sBt + (16 * nt + l15) * 40 + 8 * Q), ax, hacc[nt]);
        }
      }
      __syncthreads();
#pragma unroll
      for (int nt = 0; nt < 8; ++nt) {
        bf16x4 o;
#pragma unroll
        for (int r = 0; r < 4; ++r) o[r] = (short)f2bf(hacc[nt][r]);
        *(bf16x4*)(sH + (16 * wave + l15) * 136 + 16 * nt + 4 * Q) = o;
      }
    };
    for (int s0 = 0; s0 < TB; s0 += 64) {
      chunk(s0, pfa);
      chunk(s0 + 32, pfb);
    }
    __syncthreads();
  }
}

DI void phase_ssd_out(const Params& P, int j) {
  const int lane = ltid() & 63;
  const int gw = lbid() * 4 + (ltid() >> 6), nw = gridDim.x * 4;
  const bf16* Y0 = (const bf16*)(WSP + OFF_H);
  const bf16* Y1 = (const bf16*)(WSP + OFF_BIG) + (size_t)M * D;
  bf16* Zb = (bf16*)(WSP + OFF_BIG) + (size_t)3 * M * D;
  const float* nwp = IN(I_SSDNORM) + j * 1024;
  for (int g = gw; g < M; g += nw) {
    const size_t base = (size_t)g * D + lane * 16;
    float yv[16]; float ss = 0.f;
#pragma unroll
    for (int hh = 0; hh < 2; ++hh) {
      const bf16x8 a = *(const bf16x8*)(Y0 + base + hh * 8), c = *(const bf16x8*)(Y1 + base + hh * 8), z = *(const bf16x8*)(Zb + base + hh * 8);
#pragma unroll
      for (int e = 0; e < 8; ++e) {
        const float v = (bf2f((bf16)a[e]) + bf2f((bf16)c[e])) * siluf(bf2f((bf16)z[e]));
        yv[hh * 8 + e] = v; ss += v * v;
      }
    }
#pragma unroll
    for (int o = 16; o >= 1; o >>= 1) ss += __shfl_xor(ss, o);
    const float rs = rsqrtf(ss * (1.f / 512.f) + 1e-5f);
#pragma unroll
    for (int hh = 0; hh < 2; ++hh) {
      bf16x8 o;
#pragma unroll
      for (int e = 0; e < 8; ++e) o[e] = (short)f2bf(yv[hh * 8 + e] * rs * nwp[lane * 16 + hh * 8 + e]);
      *(bf16x8*)(Zb + base + hh * 8) = o;
    }
  }
}

DI void phase_wkv_scan(const Params& P, int j, char* smem, int cu_idx, int nact) {
  float* sR = (float*)smem;
  float* sKK = sR + 2048;
  float* sW = sKK + 2048;
  float* sBv = sW + 2048;
  float* sKd = sBv + 2048;
  float* sV = sKd + 2048;
  float* sY = sV + 2048;
  float* sKKW = sY + 1024;
  float* sRKW = sKKW + 64;
  const bf16* R = (const bf16*)(WSP + OFF_BIG);
  const bf16* K = R + (size_t)M * D;
  const bf16* V = K + (size_t)M * D;
  const bf16* TW = (const bf16*)(WSP + OFF_TW);
  const bf16* TA = (const bf16*)(WSP + OFF_TA);
  float* RKo = (float*)(WSP + OFF_RK);
  bf16* Y0 = (bf16*)(WSP + OFF_H);
  bf16* Y1 = (bf16*)(WSP + OFF_Y);
  const int tid = ltid(), lane = tid & 63, wave = tid >> 6, l15 = lane & 15, Q = lane >> 4;
  const int prow = tid >> 3, kq = tid & 7;
  if (cu_idx < 0) return;
  for (int item = cu_idx; item < 256; item += nact) {
    const int chain = item >> 1, sp = item & 1;
    const int b = chain >> 5, dir = (chain >> 4) & 1, head = chain & 15;
    const size_t gb = (size_t)b * TB;
    bf16* Yd = dir == 0 ? Y0 : Y1;
    const int hc0 = head * 64;
    const int step = dir == 0 ? 1 : -1;
    bf16x8 Bw[2], Ba[2];
    {
      const float* w2 = IN(I_W2) + (size_t)(j * 2 + dir) * 64 * 1024 + hc0 + wave * 16 + l15;
      const float* a2 = IN(I_A2) + (size_t)(j * 2 + dir) * 64 * 1024 + hc0 + wave * 16 + l15;
#pragma unroll
      for (int ks = 0; ks < 2; ++ks)
#pragma unroll
        for (int jj = 0; jj < 8; ++jj) Bw[ks][jj] = (short)f2bf(w2[(size_t)(ks * 32 + Q * 8 + jj) * 1024]);
#pragma unroll
      for (int ks = 0; ks < 2; ++ks)
#pragma unroll
        for (int jj = 0; jj < 8; ++jj) Ba[ks][jj] = (short)f2bf(a2[(size_t)(ks * 32 + Q * 8 + jj) * 1024]);
    }
    bf16x8* sFr = (bf16x8*)(smem + 55296);
    sFr[tid] = Bw[0]; sFr[256 + tid] = Bw[1]; sFr[512 + tid] = Ba[0]; sFr[768 + tid] = Ba[1];
    const int ccol = hc0 + wave * 16 + l15;
    const float w0c = IN(I_W0)[(j * 2 + dir) * 1024 + ccol];
    const float a0c = IN(I_A0)[(j * 2 + dir) * 1024 + ccol];
    const float kac = IN(I_KA)[j * 1024 + ccol];
    const int myrow = sp * 32 + prow;
    const int ta_t = tid >> 3, ta_c8 = (tid & 7) * 8;
    __syncthreads();
    if (tid < 64) { sKKW[tid] = IN(I_KK)[j * 1024 + hc0 + tid]; sRKW[tid] = IN(I_RK)[j * 1024 + hc0 + tid]; }
    __syncthreads();
    float S[8] = {0.f, 0.f, 0.f, 0.f, 0.f, 0.f, 0.f, 0.f};
    bf16x8 prv, pkv, pvv, pfw[2][2], pfa[2][2];
    auto issue = [&](int s0n) {
      const bool isctx = s0n < CL;
      const int pfirst = dir == 0 ? s0n : (isctx ? 255 - s0n : 8703 - s0n);
      const size_t gi = gb + pfirst + ta_t * step;
      prv = *(const bf16x8*)(R + gi * D + hc0 + ta_c8);
      pkv = *(const bf16x8*)(K + gi * D + hc0 + ta_c8);
      pvv = *(const bf16x8*)(V + gi * D + hc0 + ta_c8);
#pragma unroll
      for (int mt = 0; mt < 2; ++mt) {
        const size_t g2 = gb + pfirst + (mt * 16 + l15) * step;
#pragma unroll
        for (int ks = 0; ks < 2; ++ks) {
          pfw[mt][ks] = *(const bf16x8*)(TW + g2 * 128 + dir * 64 + ks * 32 + Q * 8);
          pfa[mt][ks] = *(const bf16x8*)(TA + g2 * 128 + dir * 64 + ks * 32 + Q * 8);
        }
      }
    };
    issue(0);
    for (int s0 = 0; s0 < TB; s0 += 32) {
      const bool isctx = s0 < CL;
      const int pfirst = dir == 0 ? s0 : (isctx ? 255 - s0 : 8703 - s0);
      {
        float kk[8]; float ss = 0.f;
#pragma unroll
        for (int e = 0; e < 8; ++e) { kk[e] = bf2f((bf16)pkv[e]) * sKKW[ta_c8 + e]; ss += kk[e] * kk[e]; }
        ss = red8(ss);
        const float inv = fminf(__builtin_amdgcn_rsqf(ss), 1e12f);
#pragma unroll
        for (int e = 0; e < 8; ++e) {
          sR[ta_t * 64 + ta_c8 + e] = bf2f((bf16)prv[e]);
          sKd[ta_t * 64 + ta_c8 + e] = bf2f((bf16)pkv[e]);
          sKK[ta_t * 64 + ta_c8 + e] = kk[e] * inv;
          sV[ta_t * 64 + ta_c8 + e] = bf2f((bf16)pvv[e]);
        }
      }
      f32x4 aw[2], aa[2];
#pragma unroll
      for (int mt = 0; mt < 2; ++mt) {
        aw[mt] = f32x4{0.f, 0.f, 0.f, 0.f}; aa[mt] = f32x4{0.f, 0.f, 0.f, 0.f};
#pragma unroll
        for (int ks = 0; ks < 2; ++ks) {
          aw[mt] = MFMA16(pfw[mt][ks], sFr[ks * 256 + tid], aw[mt]);
          aa[mt] = MFMA16(pfa[mt][ks], sFr[512 + ks * 256 + tid], aa[mt]);
        }
      }
      __syncthreads();
      if (s0 + 32 < TB) issue(s0 + 32);
#pragma unroll
      for (int mt = 0; mt < 2; ++mt)
#pragma unroll
        for (int r = 0; r < 4; ++r) {
          const int t = mt * 16 + Q * 4 + r, idx = t * 64 + wave * 16 + l15;
          const float wl = w0c + aw[mt][r];
          const float ee = 0.6065306597f * __builtin_amdgcn_rcpf(1.f + __expf(-wl));
          const float a = __builtin_amdgcn_rcpf(1.f + __expf(-(a0c + aa[mt][r])));
          const float kraw = sKd[idx], kk = sKK[idx];
          sW[idx] = __expf(-ee);
          sBv[idx] = kk * a;
          sKd[idx] = kraw * (1.f + (a - 1.f) * kac);
          sKK[idx] = -kk;
        }
      __syncthreads();
      if (sp == 0) {
        float s = 0.f;
#pragma unroll
        for (int e = 0; e < 8; ++e) s += sR[ta_t * 64 + ta_c8 + e] * sRKW[ta_c8 + e] * sKd[ta_t * 64 + ta_c8 + e];
        s = red8(s);
        if ((tid & 7) == 0) RKo[(gb + pfirst + ta_t * step) * 32 + dir * 16 + head] = s;
      }
      struct OPS { float4 nk0, nk1, wv0, wv1, bv0, bv1, kd0, kd1, rr0, rr1; float vv; };
      OPS oa, ob;
#define WKV_LOAD(o, ii) do { const int in_ = (ii) < 32 ? (ii) : 31; \
        (o).nk0 = *(const float4*)(sKK + in_ * 64 + kq * 8); (o).nk1 = *(const float4*)(sKK + in_ * 64 + kq * 8 + 4); \
        (o).wv0 = *(const float4*)(sW + in_ * 64 + kq * 8);  (o).wv1 = *(const float4*)(sW + in_ * 64 + kq * 8 + 4); \
        (o).bv0 = *(const float4*)(sBv + in_ * 64 + kq * 8); (o).bv1 = *(const float4*)(sBv + in_ * 64 + kq * 8 + 4); \
        (o).kd0 = *(const float4*)(sKd + in_ * 64 + kq * 8); (o).kd1 = *(const float4*)(sKd + in_ * 64 + kq * 8 + 4); \
        (o).rr0 = *(const float4*)(sR + in_ * 64 + kq * 8);  (o).rr1 = *(const float4*)(sR + in_ * 64 + kq * 8 + 4); \
        (o).vv = sV[in_ * 64 + myrow]; } while (0)
#define WKV_STEP(o, ii) do { \
        float sa = ((S[0] * (o).nk0.x + S[1] * (o).nk0.y) + (S[2] * (o).nk0.z + S[3] * (o).nk0.w)) + ((S[4] * (o).nk1.x + S[5] * (o).nk1.y) + (S[6] * (o).nk1.z + S[7] * (o).nk1.w)); \
        sa = red8(sa); \
        S[0] = S[0] * (o).wv0.x + (sa * (o).bv0.x + (o).vv * (o).kd0.x); S[1] = S[1] * (o).wv0.y + (sa * (o).bv0.y + (o).vv * (o).kd0.y); \
        S[2] = S[2] * (o).wv0.z + (sa * (o).bv0.z + (o).vv * (o).kd0.z); S[3] = S[3] * (o).wv0.w + (sa * (o).bv0.w + (o).vv * (o).kd0.w); \
        S[4] = S[4] * (o).wv1.x + (sa * (o).bv1.x + (o).vv * (o).kd1.x); S[5] = S[5] * (o).wv1.y + (sa * (o).bv1.y + (o).vv * (o).kd1.y); \
        S[6] = S[6] * (o).wv1.z + (sa * (o).bv1.z + (o).vv * (o).kd1.z); S[7] = S[7] * (o).wv1.w + (sa * (o).bv1.w + (o).vv * (o).kd1.w); \
        float y = ((S[0] * (o).rr0.x + S[1] * (o).rr0.y) + (S[2] * (o).rr0.z + S[3] * (o).rr0.w)) + ((S[4] * (o).rr1.x + S[5] * (o).rr1.y) + (S[6] * (o).rr1.z + S[7] * (o).rr1.w)); \
        y = red8(y); \
        if (kq == 0) sY[(ii) * 32 + prow] = y; } while (0)
      WKV_LOAD(oa, 0);
#pragma unroll 2
      for (int i = 0; i < 32; i += 2) {
        WKV_LOAD(ob, i + 1);
        WKV_STEP(oa, i);
        WKV_LOAD(oa, i + 2);
        WKV_STEP(ob, i + 1);
      }
#undef WKV_LOAD
#undef WKV_STEP
      __syncthreads();
      {
        const int i = tid >> 3, r4 = (tid & 7) * 4;
        const int p = pfirst + i * step;
        bf16x4 o;
        o[0] = (short)f2bf(sY[i * 32 + r4]); o[1] = (short)f2bf(sY[i * 32 + r4 + 1]); o[2] = (short)f2bf(sY[i * 32 + r4 + 2]); o[3] = (short)f2bf(sY[i * 32 + r4 + 3]);
        *(bf16x4*)(Yd + (gb + p) * D + hc0 + sp * 32 + r4) = o;
      }
    }
    __syncthreads();
  }
}

DI void phase_wkv_out(const Params& P, int j) {
  const int lane = ltid() & 63;
  const int gw = lbid() * 4 + (ltid() >> 6), nw = gridDim.x * 4;
  const bf16* Y0 = (const bf16*)(WSP + OFF_H);
  const bf16* Y1 = (const bf16*)(WSP + OFF_Y);
  bf16* R = (bf16*)(WSP + OFF_BIG);
  const bf16* V = R + (size_t)2 * M * D;
  const float* RKi = (const float*)(WSP + OFF_RK);
  const float* lnw = IN(I_LNW) + j * 1024;
  const float* lnb = IN(I_LNB) + j * 1024;
  for (int g = gw; g < M; g += nw) {
    const size_t base = (size_t)g * D + lane * 16;
    const int head = lane >> 2;
    float yv[16], vv[16]; float s = 0.f;
#pragma unroll
    for (int hh = 0; hh < 2; ++hh) {
      const bf16x8 a = *(const bf16x8*)(Y0 + base + hh * 8), c = *(const bf16x8*)(Y1 + base + hh * 8), v = *(const bf16x8*)(V + base + hh * 8);
#pragma unroll
      for (int e = 0; e < 8; ++e) { yv[hh * 8 + e] = bf2f((bf16)a[e]) + bf2f((bf16)c[e]); vv[hh * 8 + e] = bf2f((bf16)v[e]); s += yv[hh * 8 + e]; }
    }
    s = red4(s);
    const float mean = s * (1.f / 64.f);
    float q = 0.f;
#pragma unroll
    for (int e = 0; e < 16; ++e) { const float d = yv[e] - mean; q += d * d; }
    q = red4(q);
    const float rs = rsqrtf(q * (1.f / 64.f) + 64e-5f);
    const float rk = RKi[(size_t)g * 32 + head] + RKi[(size_t)g * 32 + 16 + head];
#pragma unroll
    for (int hh = 0; hh < 2; ++hh) {
      bf16x8 o;
#pragma unroll
      for (int e = 0; e < 8; ++e) {
        const int c = lane * 16 + hh * 8 + e;
        o[e] = (short)f2bf((yv[hh * 8 + e] - mean) * rs * lnw[c] + lnb[c] + rk * vv[hh * 8 + e]);
      }
      *(bf16x8*)(R + base + hh * 8) = o;
    }
  }
}

#define XB_TMO      128
#define XB_XCNT(j)  (256  + 64 * (j))
#define XB_XSUB(j)  (1280 + 64 * (j))
#define XB_XGEN(j)  (2304 + 64 * (j))
#define XB_TOP      3328
#define XB_TOPGEN   3392
#define XCD_BAR_WORDS 3456
#define XB_SPIN_CAP (1u << 23)
#define LAS __attribute__((address_space(3)))

__device__ __forceinline__ unsigned xb_ld(unsigned* p)              { return __hip_atomic_load(p, __ATOMIC_RELAXED, __HIP_MEMORY_SCOPE_AGENT); }
__device__ __forceinline__ unsigned xb_add(unsigned* p, unsigned v) { return __hip_atomic_fetch_add(p, v, __ATOMIC_RELAXED, __HIP_MEMORY_SCOPE_AGENT); }
__device__ __forceinline__ unsigned xb_xcc_id() { return (unsigned)__builtin_amdgcn_s_getreg((3 << 11) | 20) & 0xFu; }
#define XB_SPIN(cond, bar) do { unsigned _sp = 0; while (cond) { __builtin_amdgcn_s_sleep(1); \
    if ((++_sp & 255u) == 0u) { if (xb_ld(&(bar)[XB_TMO])) break; if (_sp > XB_SPIN_CAP) { atomicAdd(&(bar)[XB_TMO], 1u); break; } } } } while (0)

struct XcdBarrier {
    unsigned* bar; unsigned x;
    volatile LAS unsigned* st;
};

__device__ __forceinline__ XcdBarrier xcd_barrier_post(unsigned* bar, volatile LAS unsigned* st) {
    XcdBarrier b; b.bar = bar; b.x = xb_xcc_id(); b.st = st;
    if (threadIdx.x == 0) (void)xb_add(&bar[XB_XCNT(b.x)], 1u);
    return b;
}
__device__ __forceinline__ void xcd_barrier_complete(unsigned* bar, unsigned x, unsigned& nloc, unsigned& nx) {
    const unsigned G = gridDim.x * gridDim.y * gridDim.z;
    unsigned sum, cnt, mine, sp = 0u;
    for (;;) {
        sum = 0u; cnt = 0u; mine = 0u;
#pragma unroll
        for (unsigned j = 0; j < 16; ++j) { const unsigned c = xb_ld(&bar[XB_XCNT(j)]); sum += c; cnt += (c > 0u) ? 1u : 0u; mine = (j == x) ? c : mine; }
        if (sum == G) break;
        __builtin_amdgcn_s_sleep(1);
        if ((++sp & 255u) == 0u) { if (xb_ld(&bar[XB_TMO])) break; if (sp > XB_SPIN_CAP) { atomicAdd(&bar[XB_TMO], 1u); break; } }
    }
    nloc = mine > 0u ? mine : 1u; nx = cnt > 0u ? cnt : 1u;
}

__device__ __forceinline__ void xcd_barrier(const XcdBarrier& b) {
    asm volatile("s_waitcnt vmcnt(0)" ::: "memory");
    __syncthreads();
    if (threadIdx.x == 0) {
        unsigned* bar = b.bar;
        __builtin_amdgcn_s_waitcnt(0);
        unsigned nloc = b.st[0], nx = b.st[1];
        if (nloc == 0u) { xcd_barrier_complete(bar, b.x, nloc, nx); b.st[0] = nloc; b.st[1] = nx; }
        const unsigned old = xb_add(&bar[XB_XSUB(b.x)], 1u);
        const unsigned gen = old / nloc;
        if (old + 1u == (gen + 1u) * nloc) {
            __builtin_amdgcn_fence(__ATOMIC_RELEASE, "agent");
            asm volatile("s_waitcnt vmcnt(0)" ::: "memory");
            const unsigned og = xb_add(&bar[XB_TOP], 1u);
            const unsigned tg = og / nx;
            if (og + 1u == (tg + 1u) * nx) xb_add(&bar[XB_TOPGEN], 1u);
            else XB_SPIN(xb_ld(&bar[XB_TOPGEN]) == tg, bar);
            __builtin_amdgcn_fence(__ATOMIC_ACQUIRE, "agent");
            xb_add(&bar[XB_XGEN(b.x)], 1u);
            asm volatile("s_waitcnt vmcnt(0)" ::: "memory");
        } else {
            XB_SPIN(xb_ld(&bar[XB_XGEN(b.x)]) == gen, bar);
            __builtin_amdgcn_fence(__ATOMIC_ACQUIRE, "agent");
            asm volatile("s_waitcnt vmcnt(0)" ::: "memory");
        }
    }
    __syncthreads();
}


enum { OP_NOP = 0, OP_INIT, OP_CONVERT, OP_POSTPRE, OP_FFN_IN, OP_FFN_OUT, OP_EVENIN, OP_ATTN, OP_SSD, OP_SSDOUT, OP_EVENOUT,
       OP_MIX, OP_VMIX, OP_WKV, OP_WKVOUT, OP_GMUL, OP_WO, OP_BCCONV };
enum { KG_NONE = 0, KG_SWIGLU, KG_STORE, KG_EVENIN, KG_MIX, KG_MIXS, KG_VMIX, KG_GMUL };

__global__ void __launch_bounds__(256, 2) mega_kernel(Params P0) {
  cg::grid_group grid = cg::this_grid();
  __shared__ __attribute__((aligned(16))) char smem[73728];
  __shared__ Params sP;
  if (threadIdx.x < 40) sP.in[threadIdx.x] = P0.in[threadIdx.x];
  if (threadIdx.x == 40) sP.xlat = P0.xlat;
  if (threadIdx.x == 41) sP.ws = P0.ws;
  __shared__ uint4 xb_words;
  if (threadIdx.x == 0) xb_words = make_uint4(0u, 0u, 0u, 0u);
  __syncthreads();
  XcdBarrier xb = xcd_barrier_post((unsigned*)(P0.ws + OFF_BAR), (volatile LAS unsigned*)&xb_words);
  __shared__ int s_cu_idx, s_r1_idx;
  if (threadIdx.x == 0) {
    unsigned* tab = (unsigned*)(P0.ws + OFF_CENSUS);
    const unsigned hw = (unsigned)__builtin_amdgcn_s_getreg((15 << 11) | 4);
    const unsigned key = xb_xcc_id() * 256u + ((hw >> 8) & 0xFFu);
    const unsigned r = xb_add(&tab[key], 1u);
    s_cu_idx = (r == 0u) ? (int)xb_add(&tab[2048], 1u) : -1;
    s_r1_idx = (r == 0u) ? -1 : (int)xb_add(&tab[2049], 1u);
  }
  __syncthreads();
  const Params& P = sP;
#pragma unroll 1
  for (int pc = -3; pc < 80; ++pc) {
    bf16* H = (bf16*)(WSP + OFF_H);
    bf16* Y = (bf16*)(WSP + OFF_Y);
    bf16* BIG = (bf16*)(WSP + OFF_BIG);
    const bf16* W = (const bf16*)(WSP + OFF_W) + (size_t)((pc < 0 ? 0 : pc / 20) & 1) * W_STRIDE;
    int op = OP_NOP, arg = 0, sync = 0, l = 0;
    if (pc == -3) { op = OP_INIT; sync = 1; }
    else if (pc == -2) { op = OP_CONVERT; arg = 0; }
    else if (pc == -1) { op = OP_POSTPRE; arg = 3; sync = 1; }
    else {
      l = pc / 20;
      const int s = pc - l * 20;
      const bool odd = (l & 1) != 0;
      const int j = l >> 1;
      if (s == 0) { op = OP_FFN_IN; arg = 0; sync = 1; }
      else if (s == 1) { op = OP_FFN_OUT; arg = 0; sync = 1; }
      else if (s == 2) { op = OP_POSTPRE; arg = 0; sync = 1; }
      else if (s <= 14) {
        if (!odd) {
          if (s == 3) { op = OP_EVENIN; sync = 1; } else if (s == 4) { op = OP_ATTN; sync = 1; } else if (s == 5) { op = OP_BCCONV; sync = 1; }
          else if (s == 6) { op = OP_SSD; sync = 1; } else if (s == 7) { op = OP_SSDOUT; sync = 1; } else if (s == 8) { op = OP_EVENOUT; sync = 1; }
        } else {
          if (s <= 9) { op = OP_MIX; arg = s - 3; sync = (s == 9); if (arg == 6 && j == 0) op = OP_NOP; }
          else if (s == 10) { if (j > 0) { op = OP_VMIX; sync = 1; } }
          else if (s == 11) { op = OP_WKV; sync = 1; } else if (s == 12) { op = OP_WKVOUT; sync = 1; }
          else if (s == 13) { op = OP_GMUL; sync = 1; } else { op = OP_WO; sync = 1; }
        }
      }
      else if (s == 15) { op = OP_POSTPRE; arg = 1; sync = 1; }
      else if (s == 16) { op = OP_FFN_IN; arg = 1; sync = 1; }
      else if (s == 17) { op = OP_FFN_OUT; arg = 1; sync = 1; }
      else if (s == 18) { }
      else { op = OP_POSTPRE; arg = 2; sync = 1; }
    }
    const int j = l >> 1;
#ifndef PROBE_DUP
#define PROBE_DUP 0
#endif
    const int reps = ((PROBE_DUP >> op) & 1) ? 2 : 1;
#pragma unroll 1
    for (int rep = 0; rep < reps; ++rep) {
    GA g = make_ga(H, 1024, W, 1024, 1024, Y, 1024);
    int kind = KG_NONE;
    switch (op) {
      case OP_INIT: phase_init(P, smem); break;
      case OP_CONVERT: phase_convert(P, arg, lbid(), gridDim.x); break;
      case OP_POSTPRE:
        if (arg == 3) phase_postpre(P, false, 0, 0, 0.f, true, 0, 0, true);
        else if (arg == 0) phase_postpre(P, true, l, 0, 0.5f, true, l, 1, l == 0);
        else if (arg == 1) phase_postpre(P, true, l, 1, 1.0f, true, l, 2, false);
        else phase_postpre(P, true, l, 2, 0.5f, l < 3, l + 1, 0, false);
        break;
      case OP_FFN_IN: g = make_ga(H, 1024, W + (arg ? W_FIN1 : W_FIN0), 1024, 5632, BIG, FH); kind = KG_SWIGLU; break;
      case OP_FFN_OUT: g = make_ga(BIG, FH, W + (arg ? W_FOUT1 : W_FOUT0), FH, 1024, Y, 1024); kind = KG_STORE; break;
      case OP_EVENIN: g = make_ga(H, 1024, W + W_EIN, 1024, 5888, nullptr, 0); kind = KG_EVENIN; break;
      case OP_ATTN: phase_attn(P, j, l, smem, rep + 1 < reps); break;
      case OP_SSD: {
        const int nact = (int)xb_ld((unsigned*)(WSP + OFF_CENSUS) + 2048), nr1 = (int)gridDim.x - nact, nit = nact < 128 ? nact : 128;
        const bool scanner = s_cu_idx >= 0 && s_cu_idx < 128;
        const int ncv = (int)gridDim.x - nit;
        if (scanner) phase_ssd_chunk(P, j, smem, s_cu_idx, nit);
        if (l < 3 && (!scanner || ncv == 0))
          phase_convert(P, l + 1, ncv == 0 ? lbid() : (s_cu_idx < 0 ? s_r1_idx : nr1 + s_cu_idx - 128), ncv == 0 ? (int)gridDim.x : ncv);
      } break;
      case OP_BCCONV: phase_bcconv(P, j); break;
      case OP_SSDOUT: phase_ssd_out(P, j); break;
      case OP_EVENOUT: g = make_ga(BIG, 1024, W + W_EOUT, 2048, 1024, Y, 1024); g.A2 = BIG + (size_t)3 * M * D; g.ksplit = 1024; kind = KG_STORE; break;
      case OP_MIX: {
        const float* mu = IN(I_MU) + (size_t)j * 6 * 1024;
        bf16* R = BIG; bf16* K = BIG + (size_t)M * D; bf16* V = BIG + (size_t)2 * M * D;
        if (arg == 0) { g = make_ga(H, 1024, W + W_R, 1024, 1024, R, 1024); g.mu = mu; }
        else if (arg == 1) { g = make_ga(H, 1024, W + W_K, 1024, 1024, K, 1024); g.mu = mu + 2 * 1024; }
        else if (arg == 2) { g = make_ga(H, 1024, W + W_V, 1024, 1024, V, 1024); g.mu = mu + 3 * 1024; if (j == 0) g.o1 = (bf16*)(WSP + OFF_VF); }
        else if (arg == 3) { g = make_ga(H, 1024, W + W_W1, 1024, 128, (bf16*)(WSP + OFF_TW), 128); g.mu = mu + 1 * 1024; g.act = 1; }
        else if (arg == 4) { g = make_ga(H, 1024, W + W_A1, 1024, 128, (bf16*)(WSP + OFF_TA), 128); g.mu = mu + 4 * 1024; }
        else if (arg == 5) { g = make_ga(H, 1024, W + W_G1, 1024, 160, (bf16*)(WSP + OFF_TG), 160); g.mu = mu + 5 * 1024; g.act = 2; }
        else { g = make_ga(H, 1024, W + W_V1, 1024, 32, (bf16*)(WSP + OFF_TV), 32); g.mu = mu + 3 * 1024; }
        g.ksplit = arg == 0 ? 0 : arg == 1 ? 2112 : arg == 2 ? 4224 : arg == 3 ? 6336 : arg == 4 ? 6600 : arg == 5 ? 6864 : 7392;
        kind = KG_MIXS;
      } break;
      case OP_VMIX: g = make_ga((bf16*)(WSP + OFF_TV), 32, W + W_V2, 32, 1024, BIG + (size_t)2 * M * D, 1024); g.f0 = IN(I_V0) + (size_t)(j - 1) * 1024; kind = KG_VMIX; break;
      case OP_WKV: {
        const int nact = (int)xb_ld((unsigned*)(WSP + OFF_CENSUS) + 2048), nr1 = (int)gridDim.x - nact, nit = nact < 256 ? nact : 256;
        const bool scanner = s_cu_idx >= 0 && s_cu_idx < 256;
        const int ncv = (int)gridDim.x - nit;
        if (scanner) phase_wkv_scan(P, j, smem, s_cu_idx, nit);
        if (l < 3 && (!scanner || ncv == 0))
          phase_convert(P, l + 1, ncv == 0 ? lbid() : (s_cu_idx < 0 ? s_r1_idx : nr1 + s_cu_idx - 256), ncv == 0 ? (int)gridDim.x : ncv);
      } break;
      case OP_WKVOUT: phase_wkv_out(P, j); break;
      case OP_GMUL: g = make_ga((bf16*)(WSP + OFF_TG), 160, W + W_G2, 160, 1024, BIG, 1024); kind = KG_GMUL; break;
      case OP_WO: g = make_ga(BIG, 1024, W + W_O, 1024, 1024, Y, 1024); kind = KG_STORE; break;
      default: break;
    }
    switch (kind) {
      case KG_SWIGLU: gemm_phase<32, 0, EPI_SWIGLU, 8>(P, g, smem); break;
      case KG_STORE: gemm_phase<64, 0, EPI_STORE, 4>(P, g, smem); break;
      case KG_EVENIN: gemm_phase<64, 0, EPI_EVENIN, 4>(P, g, smem); break;

      case KG_MIXS: gemm_phase<64, 1, EPI_STORE, 4>(P, g, smem); break;
      case KG_VMIX: gemm_phase<32, 0, EPI_VMIX, 8>(P, g, smem); break;
      case KG_GMUL: gemm_phase<32, 0, EPI_GMUL, 8>(P, g, smem); break;
      default: break;
    }
    if (sync || rep + 1 < reps) { if (pc == -3) grid.sync(); else xcd_barrier(xb); }
    }
  }
}

extern "C" void kernel_launch(void* const* d_in, const int* in_sizes, int n_in, void* d_out, int out_size, void* d_ws, size_t ws_size,
                              hipStream_t stream) {
  static int grid_blocks = 0;
  if (!grid_blocks) {
    int dev = 0, cus = 0, per_cu = 0;
    hipGetDevice(&dev);
    hipDeviceGetAttribute(&cus, hipDeviceAttributeMultiprocessorCount, dev);
    hipOccupancyMaxActiveBlocksPerMultiprocessor(&per_cu, mega_kernel, 256, 0);
    if (per_cu > 2) per_cu = 2;
    if (per_cu < 1) per_cu = 1;
    grid_blocks = cus * per_cu;
  }
  if (ws_size < WS_NEED) fprintf(stderr, "workspace too small: %zu < %zu\n", ws_size, (size_t)WS_NEED);
  Params p;
  memset(&p, 0, sizeof(p));
  for (int i = 0; i < 40; ++i) p.in[i] = (const float*)d_in[i];
  p.xlat = (float*)d_out;
  p.ws = (char*)d_ws;
  hipMemsetAsync((char*)d_ws + OFF_BAR, 0, 32768, stream);
  void* args[] = {&p};
  hipError_t e = hipLaunchCooperativeKernel((void*)mega_kernel, dim3(grid_blocks), dim3(256), args, 0, stream);
  if (e != hipSuccess) fprintf(stderr, "cooperative launch failed: %s (grid %d)\n", hipGetErrorString(e), grid_blocks);
}
```
